# Optimizing an MI355X kernel written in HIP

```python
import jax, jax.numpy as jnp
from jax import lax
import numpy as np

D_MODEL = 2048
BATCH = 4
SEQ = 2048
DEPTH = 1

D_A = D_MODEL
HGRN_HEAD_DIM = 128
N_HGRN_HEADS = D_A // HGRN_HEAD_DIM
D_B = D_MODEL
CONV_GROUP_DIM = 128
N_CONV_GROUPS = D_B // CONV_GROUP_DIM
CONV_WIDTH = 3
D_MIX = D_A + D_B
CHUNK = 64
PLE_DIM = 256
EPS = 1e-6
IN_SIZES = (D_A, D_A, D_A, D_A, D_A, D_B, D_B, D_B, D_B)
D_IN_TOTAL = sum(IN_SIZES)
IN_SPLITS = tuple(int(s) for s in np.cumsum(IN_SIZES)[:-1])

kernel_name = 'hymba_hgrn2_shortconv_bidir_encoder'


def _rmsnorm(x, w):
    xf = x.astype(jnp.float32)
    xf = xf * lax.rsqrt(jnp.mean(xf * xf, axis=-1, keepdims=True) + EPS)
    return (xf * w.astype(jnp.float32)).astype(x.dtype)


def _head_rmsnorm(o, w):
    b, s, _ = o.shape
    of = o.astype(jnp.float32).reshape(b, s, N_HGRN_HEADS, HGRN_HEAD_DIM)
    of = of * lax.rsqrt(jnp.mean(of * of, axis=-1, keepdims=True) + EPS)
    return (of.reshape(b, s, D_A) * w.astype(jnp.float32)).astype(o.dtype)


def _to_chunks(t):
    b, s, _ = t.shape
    return t.reshape(b, s // CHUNK, CHUNK, N_HGRN_HEADS, HGRN_HEAD_DIM).transpose(0, 3, 1, 2, 4)


def _from_chunks(t):
    b, h, n, c, d = t.shape
    return t.transpose(0, 2, 3, 1, 4).reshape(b, n * c, h * d)


def _gla_chunked(q, k, v, log_f):
    b = jnp.cumsum(log_f, axis=-2)
    b_mid = b[..., CHUNK // 2 - 1:CHUNK // 2, :]
    b_last = b[..., -1:, :]
    q_rel = q * jnp.exp(b - b_mid)
    k_rel = k * jnp.exp(b_mid - b)
    scores = jnp.einsum('bhntk,bhnsk->bhnts', q_rel, k_rel)
    mask = jnp.tril(jnp.ones((CHUNK, CHUNK), dtype=bool))
    scores = jnp.where(mask, scores, 0.0)
    o_intra = jnp.einsum('bhnts,bhnsv->bhntv', scores, v)
    q_in = q * jnp.exp(b)
    k_st = k * jnp.exp(b_last - b)
    kv = jnp.einsum('bhnsk,bhnsv->bhnkv', k_st, v)
    decay = jnp.exp(b_last[..., 0, :])

    def step(state, inp):
        d_n, kv_n = inp
        return d_n[..., None] * state + kv_n, state

    bsz, h = q.shape[0], q.shape[1]
    s0 = jnp.zeros((bsz, h, HGRN_HEAD_DIM, HGRN_HEAD_DIM), q.dtype)
    _, s_prev = lax.scan(step, s0, (jnp.moveaxis(decay, 2, 0), jnp.moveaxis(kv, 2, 0)))
    s_prev = jnp.moveaxis(s_prev, 0, 2)
    o_inter = jnp.einsum('bhntk,bhnkv->bhntv', q_in, s_prev)
    return o_intra + o_inter


def _hgrn2_direction(q, v, f_logit, lb, reverse):
    f = lb + (1.0 - lb) * jax.nn.sigmoid(f_logit)
    log_f = jnp.log(f)
    k = 1.0 - f
    if reverse:
        q, v, k, log_f = (jnp.flip(t, axis=1) for t in (q, v, k, log_f))
    o = _from_chunks(_gla_chunked(_to_chunks(q), _to_chunks(k), _to_chunks(v), _to_chunks(log_f)))
    if reverse:
        o = jnp.flip(o, axis=1)
    return o


def _hgrn2_bidirectional(q, v, f_fwd, f_bwd, lb):
    dt = q.dtype
    q32, v32 = q.astype(jnp.float32), v.astype(jnp.float32)
    o = (_hgrn2_direction(q32, v32, f_fwd.astype(jnp.float32), lb[0], False)
         + _hgrn2_direction(q32, v32, f_bwd.astype(jnp.float32), lb[1], True))
    return o.astype(dt)


def _short_conv(u, w):
    pad = CONV_WIDTH // 2
    return lax.conv_general_dilated(
        u, w[:, None, :].astype(u.dtype), window_strides=(1,), padding=((pad, pad),),
        dimension_numbers=('NWC', 'WIO', 'NWC'), feature_group_count=D_B)


def setup_inputs(seed: int = 0) -> dict:
    key = jax.random.key(seed)
    ks = jax.random.split(key, 13)
    nrm = jax.random.normal
    return {
        'x': nrm(ks[0], (BATCH, SEQ, D_MODEL), jnp.float32),
        'p': nrm(ks[1], (DEPTH, BATCH, SEQ, PLE_DIM), jnp.float32),
        'norm_w': 1.0 + 0.02 * nrm(ks[2], (DEPTH, D_MODEL), jnp.float32),
        'w_in': nrm(ks[3], (DEPTH, D_MODEL, D_IN_TOTAL), jnp.float32) * D_MODEL ** -0.5,
        'lb_theta': 0.1 * nrm(ks[4], (2, DEPTH + 1, D_A), jnp.float32),
        'hgrn_norm_w': 1.0 + 0.02 * nrm(ks[5], (DEPTH, D_A), jnp.float32),
        'conv_w': nrm(ks[6], (DEPTH, CONV_WIDTH, D_B), jnp.float32) * CONV_WIDTH ** -0.5,
        'conv_norm_w': 1.0 + 0.02 * nrm(ks[7], (DEPTH, D_B), jnp.float32),
        'w_out': nrm(ks[8], (DEPTH, D_MIX, D_MODEL), jnp.float32) * D_MIX ** -0.5,
        'w_ple': nrm(ks[9], (DEPTH, PLE_DIM, D_MODEL), jnp.float32) * PLE_DIM ** -0.5,
        'w_ple_gate': nrm(ks[10], (DEPTH, D_MODEL, D_MODEL), jnp.float32) * D_MODEL ** -0.5,
        'final_norm_w': 1.0 + 0.02 * nrm(ks[11], (D_MODEL,), jnp.float32),
    }


def reference(x, p, norm_w, w_in, lb_theta, hgrn_norm_w, conv_w, conv_norm_w,
              w_out, w_ple, w_ple_gate, final_norm_w):
    h = x
    lb_all = jnp.cumsum(jax.nn.softmax(lb_theta.astype(jnp.float32), axis=1), axis=1)
    for i in range(DEPTH):
        hn = _rmsnorm(h, norm_w[i])
        proj = hn @ w_in[i]
        q, v, f_fwd, f_bwd, z_a, b_gate, c_gate, h_b, z_b = jnp.split(proj, IN_SPLITS, axis=-1)
        o_a = _hgrn2_bidirectional(jax.nn.silu(q), v, f_fwd, f_bwd, lb_all[:, i])
        o_a = _head_rmsnorm(o_a, hgrn_norm_w[i]) * jax.nn.silu(z_a)
        y_b = b_gate * _short_conv(c_gate * h_b, conv_w[i])
        o_b = _rmsnorm(y_b, conv_norm_w[i]) * jax.nn.silu(z_b)
        h = h + jnp.concatenate([o_a, o_b], axis=-1) @ w_out[i]
        gate = jax.nn.sigmoid(h @ w_ple_gate[i])
        h = h + (p[i] @ w_ple[i]) * gate
    return _rmsnorm(h, final_norm_w)
```

```cpp
#include <hip/hip_runtime.h>
#include <hip/hip_cooperative_groups.h>
#include <cstdio>
#include <cstdint>
namespace cg = cooperative_groups;
#ifndef REP
#define REP 0
#endif
#ifndef PHM
#define PHM 255
#endif
#ifndef MK_LAUNCHES
#define MK_LAUNCHES 1
#endif
namespace pg8 {
#define PG8_LAS __attribute__((address_space(3)))
typedef unsigned short bf16_t;
typedef short bf16x8 __attribute__((ext_vector_type(8)));
typedef float f32x4 __attribute__((ext_vector_type(4)));
typedef unsigned u32x4 __attribute__((ext_vector_type(4)));
constexpr int BM = 256, BK = 64, HALF = 128, HTB = HALF * BK * 2  , STAGE_BYTES = 8 * HTB, NXCD = 8, WGM = 8;

__host__ __device__ __forceinline__ int lds_byte(int r, int c) { const int st = (r >> 4) * 2 + (c >> 5), rr = r & 15, cc = c & 31, ob = rr * 64 + cc * 2; return st * 1024 + (ob ^ (((ob >> 9) & 1) << 5)); }
__host__ __device__ __forceinline__ void stage_rc(int b, int& R, int& C) { const int st = b / 1024, sb = b % 1024, swz = sb ^ (((sb >> 9) & 1) << 5); R = (st >> 1) * 16 + swz / 64; C = (st & 1) * 32 + (swz % 64) / 2; }
__host__ __device__ __forceinline__ int perm32(int rho) { const int n = rho >> 4, i = rho & 15; return 8 * (i >> 2) + 4 * n + (i & 3); }

struct Unit { int pm, pn; };
struct Gemm { const bf16_t* A; const bf16_t* Bt; int M, N, K; };

struct StaticOrder {
    int nM, nN, nwg, G, c;
    __host__ __device__ void init(int M, int N, int G_, int c_) { nM = M / BM; nN = N / BM; nwg = nM * nN; G = G_; c = c_; }
    __host__ __device__ bool next(int i, Unit& u) const {
        const long L = (long)i * G + c; if (L >= nwg) return false;
        int wgid = (int)L; { const int q = nwg / NXCD, r = nwg % NXCD, xcd = wgid % NXCD, off = wgid / NXCD; wgid = (xcd < r ? xcd * (q + 1) : r * (q + 1) + (xcd - r) * q) + off; }
        const int nig = WGM * nN, gid = wgid / nig, fm = gid * WGM, gsz = (nM - fm) < WGM ? (nM - fm) : WGM;
        u.pm = fm + ((wgid % nig) % gsz); u.pn = (wgid % nig) / gsz; return true;
    }
    __device__ __forceinline__ void a_ready(const Unit&) const {}
    __device__ __forceinline__ void done(const Unit&) const {}
};

__device__ __forceinline__ unsigned cvt_pk_bf16(float lo, float hi) { unsigned r; asm volatile("v_cvt_pk_bf16_f32 %0, %1, %2" : "=v"(r) : "v"(lo), "v"(hi)); return r; }
typedef float f32x2 __attribute__((ext_vector_type(2)));
__device__ __forceinline__ float sigmoidf_fast(float v) { return __builtin_amdgcn_rcpf(1.0f + __builtin_amdgcn_exp2f(-1.44269504f * v)); }

constexpr size_t SECN = (size_t)8192 * 2048;
struct EpiProj {
    static constexpr bool PERM = true, AFTER_DRAIN = false;
    bf16_t* O; const float* LBO;
    __device__ __forceinline__ void operator()(const f32x4 (&acc)[2][2][4][2], const Unit& u, int wr, int wc, int fr, int fq) const {
        const int row0 = u.pm * BM + wr * 64 + fr; int colt = u.pn * BM; const int sec = colt >> 11; colt -= sec << 11;
        bf16_t* base = O + (size_t)sec * SECN; const int col0 = colt + wc * 32 + 8 * fq;
#pragma unroll
        for (int ai = 0; ai < 2; ++ai)
#pragma unroll
            for (int m = 0; m < 4; ++m) { bf16_t* rowp = base + (size_t)(row0 + ai * HALF + m * 16) * 2048 + col0;
#pragma unroll
                for (int bj = 0; bj < 2; ++bj) { f32x4 v0 = acc[ai][bj][m][0], v1 = acc[ai][bj][m][1];
                    if (sec == 0) {
#pragma unroll
                        for (int j = 0; j < 4; ++j) { v0[j] = v0[j] * sigmoidf_fast(v0[j]); v1[j] = v1[j] * sigmoidf_fast(v1[j]); } }
                    if (sec == 2 || sec == 3) { const float* tp = LBO + (sec - 2) * 4096 + col0 + bj * HALF;
                        const f32x4 a0 = *(const f32x4*)(tp), a1 = *(const f32x4*)(tp + 4), b0 = *(const f32x4*)(tp + 2048), b1 = *(const f32x4*)(tp + 2048 + 4);
#pragma unroll
                        for (int j = 0; j < 4; ++j) { v0[j] = sigmoidf_fast(b0[j] - a0[j]) * sigmoidf_fast(-v0[j]); v1[j] = sigmoidf_fast(b1[j] - a1[j]) * sigmoidf_fast(-v1[j]); } }
                    u32x4 w; w.x = cvt_pk_bf16(v0[0], v0[1]); w.y = cvt_pk_bf16(v0[2], v0[3]); w.z = cvt_pk_bf16(v1[0], v1[1]); w.w = cvt_pk_bf16(v1[2], v1[3]);
                    *(u32x4*)(rowp + bj * HALF) = w; } }
    }
};
struct EpiH {
    static constexpr bool PERM = true, AFTER_DRAIN = false;
    const float* X; float* H; bf16_t* HB;
    __device__ __forceinline__ void operator()(const f32x4 (&acc)[2][2][4][2], const Unit& u, int wr, int wc, int fr, int fq) const {
        const int row0 = u.pm * BM + wr * 64 + fr; const int col0 = u.pn * BM + wc * 32 + 8 * fq;
#pragma unroll
        for (int ai = 0; ai < 2; ++ai)
#pragma unroll
            for (int m = 0; m < 4; ++m) { const size_t off = (size_t)(row0 + ai * HALF + m * 16) * 2048 + col0;
#pragma unroll
                for (int bj = 0; bj < 2; ++bj) { const f32x4 x0 = *(const f32x4*)(X + off + bj * HALF), x1 = *(const f32x4*)(X + off + bj * HALF + 4);
                    const f32x4 v0 = acc[ai][bj][m][0] + x0, v1 = acc[ai][bj][m][1] + x1;
                    *(f32x4*)(H + off + bj * HALF) = v0; *(f32x4*)(H + off + bj * HALF + 4) = v1;
                    u32x4 w; w.x = cvt_pk_bf16(v0[0], v0[1]); w.y = cvt_pk_bf16(v0[2], v0[3]); w.z = cvt_pk_bf16(v1[0], v1[1]); w.w = cvt_pk_bf16(v1[2], v1[3]);
                    *(u32x4*)(HB + off + bj * HALF) = w; } }
    }
};
struct EpiPle {
    static constexpr bool PERM = true, AFTER_DRAIN = false;
    bf16_t* O;
    __device__ __forceinline__ void operator()(const f32x4 (&acc)[2][2][4][2], const Unit& u, int wr, int wc, int fr, int fq) const {
        const int row0 = u.pm * BM + wr * 64 + fr; const int col0 = u.pn * BM + wc * 32 + 8 * fq;
#pragma unroll
        for (int ai = 0; ai < 2; ++ai)
#pragma unroll
            for (int m = 0; m < 4; ++m) { const size_t off = (size_t)(row0 + ai * HALF + m * 16) * 2048 + col0;
#pragma unroll
                for (int bj = 0; bj < 2; ++bj) { const f32x4 v0 = acc[ai][bj][m][0], v1 = acc[ai][bj][m][1];
                    u32x4 w; w.x = cvt_pk_bf16(v0[0], v0[1]); w.y = cvt_pk_bf16(v0[2], v0[3]); w.z = cvt_pk_bf16(v1[0], v1[1]); w.w = cvt_pk_bf16(v1[2], v1[3]);
                    *(u32x4*)(O + off + bj * HALF) = w; } }
    }
};
struct EpiGate {
    static constexpr bool PERM = true, AFTER_DRAIN = false;
    const float* H; const bf16_t* PL; float* O; float* PART;
    __device__ __forceinline__ void operator()(const f32x4 (&acc)[2][2][4][2], const Unit& u, int wr, int wc, int fr, int fq) const {
        const int row0 = u.pm * BM + wr * 64 + fr; const int col0 = u.pn * BM + wc * 32 + 8 * fq;
#pragma unroll
        for (int ai = 0; ai < 2; ++ai)
#pragma unroll
            for (int m = 0; m < 4; ++m) { const int row = row0 + ai * HALF + m * 16; const size_t off = (size_t)row * 2048 + col0; float ss = 0.f;
#pragma unroll
                for (int bj = 0; bj < 2; ++bj) {
                    const f32x4 h0 = *(const f32x4*)(H + off + bj * HALF), h1 = *(const f32x4*)(H + off + bj * HALF + 4);
                    const u32x4 pw = *(const u32x4*)(PL + off + bj * HALF);
                    const f32x4 p0 = (f32x4){__uint_as_float(pw.x << 16), __uint_as_float(pw.x & 0xffff0000u), __uint_as_float(pw.y << 16), __uint_as_float(pw.y & 0xffff0000u)};
                    const f32x4 p1 = (f32x4){__uint_as_float(pw.z << 16), __uint_as_float(pw.z & 0xffff0000u), __uint_as_float(pw.w << 16), __uint_as_float(pw.w & 0xffff0000u)};
                    f32x4 v0, v1;
#pragma unroll
                    for (int j = 0; j < 4; ++j) { v0[j] = h0[j] + p0[j] * sigmoidf_fast(acc[ai][bj][m][0][j]); v1[j] = h1[j] + p1[j] * sigmoidf_fast(acc[ai][bj][m][1][j]);
                        ss += v0[j] * v0[j] + v1[j] * v1[j]; }
                    *(f32x4*)(O + off + bj * HALF) = v0; *(f32x4*)(O + off + bj * HALF + 4) = v1; }
                ss += __shfl_xor(ss, 16); ss += __shfl_xor(ss, 32);
                if (fq == 0) PART[(size_t)row * 32 + u.pn * 4 + wc] = ss; }
    }
};

template <class Epi, class Sched, bool ALIGN_EPI = false, bool SP2 = false>
__device__ __forceinline__ void gemm_phase(PG8_LAS unsigned char* lds, const Gemm g, const Sched& S, const Epi& E) {
    const int tid = threadIdx.x, wid = __builtin_amdgcn_readfirstlane(tid >> 6), lane = tid & 63, wr = wid >> 2, wc = wid & 3, fr = lane & 15, fq = lane >> 4;
    const int K = g.K, nt = K / BK;
    unsigned voffA[2], voffB[2];
#pragma unroll
    for (int i = 0; i < 2; ++i) { int R, C; stage_rc(tid * 16 + i * 8192, R, C); const int Rb = Epi::PERM ? ((R & ~31) + perm32(R & 31)) : R;
        voffA[i] = (unsigned)(R * K + C) * 2u; voffB[i] = (unsigned)(Rb * K + C) * 2u; }
    const size_t kstep = (size_t)(BK * 2);
    const size_t hstep = (size_t)HALF * K * 2;
    const size_t tstep = 2 * hstep;
    const unsigned ldsw = (unsigned)wid * 1024u;
    const int aoff = lds_byte(wr * 64 + fr, fq * 8), boff = lds_byte(wc * 32 + fr, fq * 8);
#define PG8_SA(b, h) (((b) * 2 + (h)) * HTB)
#define PG8_SB(b, h) ((4 + (b) * 2 + (h)) * HTB)
#define PG8_STAGE(bufoff, gbase, voff) do { _Pragma("unroll") for (int _i = 0; _i < 2; ++_i) \
        __builtin_amdgcn_global_load_lds((const unsigned*)((const char*)(gbase) + (voff)[_i]), (PG8_LAS unsigned*)(lds + (bufoff) + ldsw + _i * 8192), 16, 0, 0); } while (0)
#define PG8_LDA(dst, b, h) do { _Pragma("unroll") for (int m = 0; m < 4; ++m) _Pragma("unroll") for (int k = 0; k < 2; ++k) dst[m][k] = *(const PG8_LAS bf16x8*)(lds + PG8_SA(b, h) + aoff + m * 2048 + k * 1024); } while (0)
#define PG8_LDB(dst, b, h) do { _Pragma("unroll") for (int n = 0; n < 2; ++n) _Pragma("unroll") for (int k = 0; k < 2; ++k) dst[n][k] = *(const PG8_LAS bf16x8*)(lds + PG8_SB(b, h) + boff + n * 2048 + k * 1024); } while (0)
#define PG8_MMA(ai, bj, At, Bt) do { __builtin_amdgcn_s_setprio(1); _Pragma("unroll") for (int m = 0; m < 4; ++m) _Pragma("unroll") for (int n = 0; n < 2; ++n) _Pragma("unroll") for (int k = 0; k < 2; ++k) \
        acc[ai][bj][m][n] = __builtin_amdgcn_mfma_f32_16x16x32_bf16(Bt[n][k], At[m][k], acc[ai][bj][m][n], 0, 0, 0); __builtin_amdgcn_s_setprio(0); } while (0)
#define PG8_WAIT_V(n) asm volatile("s_waitcnt vmcnt(" #n ")" ::: "memory")
#define PG8_WAIT_L(n) asm volatile("s_waitcnt lgkmcnt(" #n ")" ::: "memory")
#define PG8_BAR __builtin_amdgcn_s_barrier()
#define PG8_SCHED __builtin_amdgcn_sched_barrier(0)
    Unit cur, nxt; int ui = 0;
    if (!S.next(0, cur)) return;
    f32x4 acc[2][2][4][2];
#pragma unroll
    for (int a = 0; a < 2; ++a)
#pragma unroll
        for (int b = 0; b < 2; ++b)
#pragma unroll
            for (int m = 0; m < 4; ++m)
#pragma unroll
                for (int n = 0; n < 2; ++n) acc[a][b][m][n] = (f32x4){0.f, 0.f, 0.f, 0.f};
    bf16x8 At[4][2], B0[2][2], B1[2][2];
    const char* cA = (const char*)g.A + (size_t)cur.pm * tstep; const char* cB = (const char*)g.Bt + (size_t)cur.pn * tstep;
    S.a_ready(cur);
    if constexpr (SP2) {
        PG8_STAGE(PG8_SB(0, 0), cB, voffB); PG8_STAGE(PG8_SB(0, 1), cB + hstep, voffB); PG8_STAGE(PG8_SA(0, 0), cA, voffA); PG8_STAGE(PG8_SA(0, 1), cA + hstep, voffA);
        if (wr == 1) PG8_BAR;
        PG8_WAIT_V(2); PG8_BAR;
        PG8_STAGE(PG8_SB(1, 0), cB + kstep, voffB); PG8_STAGE(PG8_SA(1, 0), cA + kstep, voffA); PG8_STAGE(PG8_SB(1, 1), cB + hstep + kstep, voffB);
        PG8_WAIT_V(6); PG8_BAR;
    } else {
        PG8_STAGE(PG8_SB(0, 0), cB, voffB); PG8_STAGE(PG8_SA(0, 0), cA, voffA); PG8_STAGE(PG8_SB(0, 1), cB + hstep, voffB); PG8_STAGE(PG8_SA(0, 1), cA + hstep, voffA);
        if (wr == 1) PG8_BAR;
        PG8_WAIT_V(4); PG8_BAR;
        PG8_STAGE(PG8_SB(1, 0), cB + kstep, voffB); PG8_STAGE(PG8_SA(1, 0), cA + kstep, voffA); PG8_STAGE(PG8_SB(1, 1), cB + hstep + kstep, voffB);
        PG8_WAIT_V(6); PG8_BAR;
    }
    for (;;) {
        const bool has_next = S.next(ui + 1, nxt);
        const char* nA = has_next ? (const char*)g.A + (size_t)nxt.pm * tstep : cA; const char* nB = has_next ? (const char*)g.Bt + (size_t)nxt.pn * tstep : cB;
        for (int t = 0; t < nt; t += 2) {
            const bool last = (t == nt - 2);
            const char* a1 = cA + (size_t)(t + 1) * kstep;
            const char* a2 = last ? nA : cA + (size_t)(t + 2) * kstep; const char* b2 = last ? nB : cB + (size_t)(t + 2) * kstep;
            const char* a3 = a2 + kstep; const char* b3 = b2 + kstep;
            if (last && has_next) S.a_ready(nxt);
            if constexpr (SP2) {
            PG8_LDB(B0, 0, 0); PG8_LDB(B1, 0, 1); PG8_SCHED; PG8_LDA(At, 0, 0); PG8_STAGE(PG8_SA(1, 1), a1 + hstep, voffA);
            PG8_WAIT_V(8); PG8_WAIT_L(0); PG8_BAR; PG8_MMA(0, 0, At, B0); PG8_MMA(0, 1, At, B1); PG8_BAR; PG8_SCHED;
            PG8_LDA(At, 0, 1); PG8_STAGE(PG8_SB(0, 0), b2, voffB); PG8_STAGE(PG8_SB(0, 1), b2 + hstep, voffB); PG8_STAGE(PG8_SA(0, 0), a2, voffA);
            PG8_WAIT_V(8); PG8_WAIT_L(0); PG8_BAR; PG8_MMA(1, 0, At, B0); PG8_MMA(1, 1, At, B1); PG8_BAR; PG8_SCHED;
            PG8_LDB(B0, 1, 0); PG8_LDB(B1, 1, 1); PG8_SCHED; PG8_LDA(At, 1, 0); PG8_STAGE(PG8_SA(0, 1), a2 + hstep, voffA);
            PG8_WAIT_V(8); PG8_WAIT_L(0); PG8_BAR; PG8_MMA(0, 0, At, B0); PG8_MMA(0, 1, At, B1); PG8_BAR; PG8_SCHED;
            PG8_LDA(At, 1, 1); PG8_STAGE(PG8_SB(1, 0), b3, voffB); PG8_STAGE(PG8_SB(1, 1), b3 + hstep, voffB); PG8_STAGE(PG8_SA(1, 0), a3, voffA);
            PG8_WAIT_V(8); PG8_WAIT_L(0); PG8_BAR; PG8_MMA(1, 0, At, B0); PG8_MMA(1, 1, At, B1); PG8_BAR; PG8_SCHED;
            } else {
            PG8_LDB(B0, 0, 0); PG8_SCHED; PG8_LDA(At, 0, 0); PG8_STAGE(PG8_SA(1, 1), a1 + hstep, voffA);
            PG8_WAIT_L(8); PG8_BAR; PG8_WAIT_L(0); PG8_MMA(0, 0, At, B0); PG8_BAR; PG8_SCHED;
            PG8_LDB(B1, 0, 1); PG8_STAGE(PG8_SB(0, 0), b2, voffB);
            PG8_BAR; PG8_WAIT_L(0); PG8_MMA(0, 1, At, B1); PG8_BAR;
            PG8_LDA(At, 0, 1); PG8_STAGE(PG8_SA(0, 0), a2, voffA);
            PG8_BAR; PG8_WAIT_L(0); PG8_MMA(1, 0, At, B0); PG8_BAR; PG8_SCHED;
            PG8_STAGE(PG8_SB(0, 1), b2 + hstep, voffB);
            PG8_WAIT_V(6); PG8_BAR; PG8_MMA(1, 1, At, B1); PG8_BAR;
            PG8_LDB(B0, 1, 0); PG8_SCHED; PG8_LDA(At, 1, 0); PG8_STAGE(PG8_SA(0, 1), a2 + hstep, voffA);
            PG8_WAIT_L(8); PG8_BAR; PG8_WAIT_L(0); PG8_MMA(0, 0, At, B0); PG8_BAR; PG8_SCHED;
            PG8_LDB(B1, 1, 1); PG8_STAGE(PG8_SB(1, 0), b3, voffB);
            PG8_BAR; PG8_WAIT_L(0); PG8_MMA(0, 1, At, B1); PG8_BAR;
            PG8_LDA(At, 1, 1); PG8_STAGE(PG8_SA(1, 0), a3, voffA);
            PG8_BAR; PG8_WAIT_L(0); PG8_MMA(1, 0, At, B0); PG8_BAR; PG8_SCHED;
            PG8_STAGE(PG8_SB(1, 1), b3 + hstep, voffB);
            PG8_WAIT_V(6); PG8_BAR; PG8_MMA(1, 1, At, B1); PG8_BAR;
            }
        }
        if constexpr (ALIGN_EPI) { if (wr == 0) PG8_BAR; }
        if constexpr (!Epi::AFTER_DRAIN) { E(acc, cur, wr, wc, fr, fq); S.done(cur); }
        if (!has_next) break;
#pragma unroll
        for (int a = 0; a < 2; ++a)
#pragma unroll
            for (int b = 0; b < 2; ++b)
#pragma unroll
                for (int m = 0; m < 4; ++m)
#pragma unroll
                    for (int n = 0; n < 2; ++n) acc[a][b][m][n] = (f32x4){0.f, 0.f, 0.f, 0.f};
        cur = nxt; cA = nA; cB = nB; ++ui;
        if constexpr (ALIGN_EPI) { if (wr == 1) PG8_BAR; }
    }
    PG8_WAIT_V(0);
    if constexpr (!ALIGN_EPI) { if (wr == 0) PG8_BAR; }
    PG8_BAR;
    if constexpr (Epi::AFTER_DRAIN) { E.fused(acc, cur, wr, wc, fr, fq, lds, wid, lane); S.done(cur); }
#undef PG8_SA
#undef PG8_SB
#undef PG8_STAGE
#undef PG8_LDA
#undef PG8_LDB
#undef PG8_MMA
#undef PG8_WAIT_V
#undef PG8_WAIT_L
#undef PG8_BAR
#undef PG8_SCHED
}
}
#define LAS __attribute__((address_space(3)))
typedef unsigned short bf16_t;
typedef unsigned v4u __attribute__((ext_vector_type(4)));
typedef unsigned v2u __attribute__((ext_vector_type(2)));
typedef float f32x4 __attribute__((ext_vector_type(4)));
typedef float f32x2 __attribute__((ext_vector_type(2)));
typedef short bf16x8 __attribute__((ext_vector_type(8)));
constexpr int MTOK = 8192, DM = 2048, NIN = 18432, DMIX = 4096, PLED = 256, SEQL = 2048;
constexpr size_t MiB = (size_t)1 << 20;
constexpr size_t SECN = (size_t)MTOK * 2048;
constexpr size_t WS_WIN = 0, WS_HN = 72 * MiB, WS_WOUT = 104 * MiB, WS_WG = 120 * MiB, WS_WP = 128 * MiB, WS_PB = 129 * MiB;
constexpr size_t WS_PROJ = 136 * MiB, WS_OF = 424 * MiB, WS_PART = 552 * MiB, WS_CTL = 553 * MiB, WS_LBO = WS_CTL + 65536, WS_END = 554 * MiB;
constexpr size_t WS_CAT = WS_PROJ, WS_H = WS_PROJ + 64 * MiB, WS_HB = WS_WIN;
constexpr int MISC_OFF = 156672, LDS_BYTES = MISC_OFF + 64;
constexpr float EPSV = 1e-6f;
#define LDS_WAIT() asm volatile("s_waitcnt lgkmcnt(0)" ::: "memory")

__device__ __forceinline__ unsigned pk2(float lo, float hi) { unsigned r; asm volatile("v_cvt_pk_bf16_f32 %0, %1, %2" : "=v"(r) : "v"(lo), "v"(hi)); return r; }
__device__ __forceinline__ float bf_lo(unsigned u) { return __uint_as_float(u << 16); }
__device__ __forceinline__ float bf_hi(unsigned u) { return __uint_as_float(u & 0xffff0000u); }
__device__ __forceinline__ float wave_sum(float v) {
#pragma unroll
    for (int o = 1; o < 64; o <<= 1) v += __shfl_xor(v, o);
    return v;
}
__device__ __forceinline__ float sigm(float v) { return __builtin_amdgcn_rcpf(1.0f + __builtin_amdgcn_exp2f(-1.44269504f * v)); }

struct Args { const float* in[12]; float* out; unsigned char* ws; int ph_lo, ph_hi; };

__device__ __forceinline__ void transpose_item(const float* W, int K, int N, bf16_t* WT, LAS float* scr, int item, int lane) {
    const int nblk = N / 32, kb = item / nblk, nb = item % nblk, k0 = 64 * kb, n0 = 32 * nb;
#pragma unroll 8
    for (int i = 0; i < 32; ++i) { const int kk = 2 * i + (lane >> 5); scr[kk * 33 + (lane & 31)] = W[(size_t)(k0 + kk) * N + n0 + (lane & 31)]; }
    LDS_WAIT();
    const int c = lane & 7;
#pragma unroll
    for (int j = 0; j < 4; ++j) { const int n = (lane >> 3) + 8 * j; const LAS float* s = scr + (8 * c) * 33 + n;
        v4u o; o.x = pk2(s[0 * 33], s[1 * 33]); o.y = pk2(s[2 * 33], s[3 * 33]); o.z = pk2(s[4 * 33], s[5 * 33]); o.w = pk2(s[6 * 33], s[7 * 33]);
        *(v4u*)(WT + (size_t)(n0 + n) * K + k0 + 8 * c) = o; }
    LDS_WAIT();
}
__device__ __forceinline__ void prep_phase(LAS unsigned char* lds, const Args& a, int bid, int nblk) {
    const int lane = threadIdx.x & 63, w = threadIdx.x >> 6;
    LAS float* scr = (LAS float*)(lds + w * 8704);
    const int gw = bid * 8 + w, NGW = nblk * 8;
    unsigned char* ws = a.ws;
    constexpr int I_IN = (DM / 64) * (NIN / 32), I_OUT = (DMIX / 64) * (DM / 32), I_G = (DM / 64) * (DM / 32), I_P = (PLED / 64) * (DM / 32);
    for (int it = gw; it < I_IN + I_OUT + I_G + I_P; it += NGW) {
        int r = it;
        if (r < I_IN) { transpose_item(a.in[3], DM, NIN, (bf16_t*)(ws + WS_WIN), scr, r, lane); continue; } r -= I_IN;
        if (r < I_OUT) { transpose_item(a.in[8], DMIX, DM, (bf16_t*)(ws + WS_WOUT), scr, r, lane); continue; } r -= I_OUT;
        if (r < I_G) { transpose_item(a.in[10], DM, DM, (bf16_t*)(ws + WS_WG), scr, r, lane); continue; } r -= I_G;
        transpose_item(a.in[9], PLED, DM, (bf16_t*)(ws + WS_WP), scr, r, lane);
    }
    const float* x = a.in[0]; const float* nw = a.in[2]; bf16_t* hn = (bf16_t*)(ws + WS_HN);
    for (int row = gw; row < MTOK; row += NGW) {
        const f32x4* xr = (const f32x4*)(x + (size_t)row * DM) + lane;
        f32x4 v[8]; float s = 0.f;
#pragma unroll
        for (int j = 0; j < 8; ++j) { v[j] = xr[64 * j]; s += (v[j].x * v[j].x + v[j].y * v[j].y) + (v[j].z * v[j].z + v[j].w * v[j].w); }
        const float rstd = __builtin_amdgcn_rsqf(wave_sum(s) * (1.f / DM) + EPSV);
        v2u* o = (v2u*)(hn + (size_t)row * DM) + lane;
#pragma unroll
        for (int j = 0; j < 8; ++j) { const f32x4 g = *((const f32x4*)nw + lane + 64 * j);
            v2u q; q.x = pk2(v[j].x * rstd * g.x, v[j].y * rstd * g.y); q.y = pk2(v[j].z * rstd * g.z, v[j].w * rstd * g.w); o[64 * j] = q; }
    }
    const f32x4* p4 = (const f32x4*)a.in[1]; v2u* pb = (v2u*)(ws + WS_PB);
    for (int i = gw * 64 + lane; i < MTOK * PLED / 4; i += NGW * 64) { const f32x4 v = p4[i]; v2u q; q.x = pk2(v.x, v.y); q.y = pk2(v.z, v.w); pb[i] = q; }
}

constexpr int SQ = 136, SK = 72;
constexpr int B_QR = 0, B_KR = 17408, B_KRT = 34816, B_VT = 53248, BUF_SZ = 62464;
constexpr int P2_P = 2 * BUF_SZ, P2_ST = P2_P + 9216, P2_SEG = P2_ST + 17408, P2_CH = P2_SEG + 2048;
static_assert(P2_CH + 2 * 1536 <= MISC_OFF, "P2 LDS map");
#define MFMA16(a, b, c) __builtin_amdgcn_mfma_f32_16x16x32_bf16(a, b, c, 0, 0, 0)
#define LBAR() do { asm volatile("s_waitcnt lgkmcnt(0)" ::: "memory"); __builtin_amdgcn_s_barrier(); asm volatile("" ::: "memory"); } while (0)
__device__ __forceinline__ bf16x8 frag(LAS unsigned char* lds, int base, int r0, int ks, int rs, int fr, int fq) { return *(const LAS bf16x8*)(lds + base + ((r0 + fr) * rs + ks * 32 + 8 * fq) * 2); }

__device__ __forceinline__ void hgrn_phase(LAS unsigned char* lds, const Args& a, int bid, int nblk) {
    const int tid = threadIdx.x, lane = tid & 63, w = __builtin_amdgcn_readfirstlane(tid >> 6), fr = lane & 15, fq = lane >> 4;
    const bool prod = w < 4;
    const int pw = w & 3, cw = w & 3, cp = lane, ptid = pw * 64 + lane, vcp = ptid & 31, sseg = ptid >> 5;
    const bf16_t* proj = (const bf16_t*)(a.ws + WS_PROJ);
    for (int item = bid; item < 256; item += nblk) {
        const int vh = item & 1, dir = (item >> 1) & 1, h = (item >> 2) & 15, b = item >> 6;
        const bf16_t* qb = proj + h * 128; const bf16_t* fb = proj + (size_t)(2 + dir) * SECN + h * 128; const bf16_t* vb = proj + SECN + h * 128 + vh * 64;
        const unsigned qlo = 2 * cp, vlo = (dir ? 8 * (1 - (lane >> 5)) : 8 * (lane >> 5)) * 2048 + 2 * vcp;
        float* ob = (float*)(a.ws + WS_OF) + (size_t)dir * SECN + h * 128 + vh * 64;
        const int tokbase = b * SEQL;
        for (int i = tid; i < 2304; i += 512) ((LAS unsigned*)(lds + P2_P))[i] = 0u;
        f32x4 S[2][4];
#pragma unroll
        for (int ct = 0; ct < 2; ++ct)
#pragma unroll
            for (int nt = 0; nt < 4; ++nt) S[ct][nt] = (f32x4){0.f, 0.f, 0.f, 0.f};
        unsigned qreg[16], freg[16], vreg[8];
#define P2_LOAD(n) do { const int c0 = tokbase + 64 * (dir ? 31 - (n) : (n)); \
            _Pragma("unroll") for (int i = 0; i < 16; ++i) { const size_t tk = (size_t)(dir ? c0 + 63 - 16 * pw - i : c0 + 16 * pw + i) * 2048; qreg[i] = *(const unsigned*)(qb + tk + qlo); freg[i] = *(const unsigned*)(fb + tk + qlo); } \
            _Pragma("unroll") for (int i = 0; i < 8; ++i) { const size_t tk = (size_t)(dir ? c0 + 55 - 16 * pw - i : c0 + 16 * pw + i) * 2048; vreg[i] = *(const unsigned*)(vb + tk + vlo); } } while (0)
        if (prod) P2_LOAD(0);
        for (int step = -1; step < 32; ++step) {
            const int n1 = step + 1;
            unsigned qc[16], fc[16], vc[8];
            if (prod) {
                if (n1 < 32) {
#pragma unroll
                    for (int i = 0; i < 16; ++i) { qc[i] = qreg[i]; fc[i] = freg[i]; }
#pragma unroll
                    for (int i = 0; i < 8; ++i) vc[i] = vreg[i];
                    if (n1 + 1 < 32) P2_LOAD(n1 + 1);
                    float run[2] = {1.f, 1.f};
#pragma unroll
                    for (int i = 0; i < 16; ++i)
#pragma unroll
                        for (int e = 0; e < 2; ++e) { const float kv = e ? bf_hi(fc[i]) : bf_lo(fc[i]); run[e] *= (1.f - kv); }
                    f32x2 t; t.x = run[0]; t.y = run[1]; *(LAS f32x2*)(lds + P2_SEG + (pw * 128 + 2 * cp) * 4) = t;
                }
            } else if (step >= 0) {
                const int base = (step & 1) * BUF_SZ, ch = P2_CH + (step & 1) * 1536;
#pragma unroll
                for (int ct = 0; ct < 2; ++ct) { const f32x4 em = *(const LAS f32x4*)(lds + ch + (32 * cw + 16 * ct + 4 * fq) * 4);
#pragma unroll
                    for (int nt = 0; nt < 4; ++nt) { const f32x4 v = S[ct][nt] * em; v2u z; z.x = pk2(v[0], v[1]); z.y = pk2(v[2], v[3]);
                        *(LAS v2u*)(lds + P2_ST + ((16 * nt + fr) * SQ + 32 * cw + 16 * ct + 4 * fq) * 2) = z; } }
#pragma unroll
                for (int sl = 0; sl < 3; ++sl) {
                    int ti, sj; bool valid = true;
                    if (sl == 0) { ti = cw < 2 ? 3 : 2; sj = (cw & 1) * 2; }
                    else if (sl == 1) { ti = cw == 3 ? 1 : (cw < 2 ? 3 : 2); sj = cw == 3 ? 1 : (cw & 1) * 2 + 1; }
                    else { ti = cw == 0 ? 0 : 1; sj = 0; valid = !(cw & 1); }
                    if (valid) { const int t0 = 16 * ti, s0 = 16 * sj; f32x4 acc = (f32x4){0.f, 0.f, 0.f, 0.f};
#pragma unroll
                        for (int ks = 0; ks < 4; ++ks) acc = MFMA16(frag(lds, base + B_KR, s0, ks, SQ, fr, fq), frag(lds, base + B_QR, t0, ks, SQ, fr, fq), acc);
                        if (ti == sj) {
#pragma unroll
                            for (int j = 0; j < 4; ++j) acc[j] = (4 * fq + j <= fr) ? acc[j] : 0.f; }
                        v2u z; z.x = pk2(acc[0], acc[1]); z.y = pk2(acc[2], acc[3]); *(LAS v2u*)(lds + P2_P + ((t0 + fr) * SK + s0 + 4 * fq) * 2) = z; }
                }
#pragma unroll
                for (int ct = 0; ct < 2; ++ct) {
                    const f32x4 el = *(const LAS f32x4*)(lds + ch + 512 + (32 * cw + 16 * ct + 4 * fq) * 4), g4 = *(const LAS f32x4*)(lds + ch + 1024 + (32 * cw + 16 * ct + 4 * fq) * 4);
                    f32x4 tm[4];
#pragma unroll
                    for (int nt = 0; nt < 4; ++nt) tm[nt] = (f32x4){0.f, 0.f, 0.f, 0.f};
#pragma unroll
                    for (int ks = 0; ks < 2; ++ks) { const bf16x8 ak = frag(lds, base + B_KRT, 32 * cw + 16 * ct, ks, SK, fr, fq);
#pragma unroll
                        for (int nt = 0; nt < 4; ++nt) tm[nt] = MFMA16(ak, frag(lds, base + B_VT, 16 * nt, ks, SK, fr, fq), tm[nt]); }
#pragma unroll
                    for (int nt = 0; nt < 4; ++nt) S[ct][nt] = el * S[ct][nt] + g4 * tm[nt];
                }
            }
            LBAR();
            if (prod) {
                if (n1 < 32) {
                    const int base = (n1 & 1) * BUF_SZ, ch = P2_CH + (n1 & 1) * 1536;
                    float off[2] = {1.f, 1.f}, emid[2], elast[2];
                    f32x2 sgv[4];
#pragma unroll
                    for (int s4 = 0; s4 < 4; ++s4) sgv[s4] = *(const LAS f32x2*)(lds + P2_SEG + (s4 * 128 + 2 * cp) * 4);
#pragma unroll
                    for (int s4 = 0; s4 < 4; ++s4) if (s4 < pw) { off[0] *= sgv[s4].x; off[1] *= sgv[s4].y; }
                    emid[0] = sgv[0].x * sgv[1].x; emid[1] = sgv[0].y * sgv[1].y; elast[0] = emid[0] * sgv[2].x * sgv[3].x; elast[1] = emid[1] * sgv[2].y * sgv[3].y;
                    const float rmid[2] = {__builtin_amdgcn_rcpf(emid[0]), __builtin_amdgcn_rcpf(emid[1])};
#pragma unroll
                    for (int hf = 0; hf < 2; ++hf) {
                        float bl[8][2];
#pragma unroll
                        for (int i8 = 0; i8 < 8; ++i8) { const int i = 8 * hf + i8;
                            float qr[2];
#pragma unroll
                            for (int e = 0; e < 2; ++e) { const float kv = e ? bf_hi(fc[i]) : bf_lo(fc[i]); off[e] *= (1.f - kv); const float E3 = off[e], rE = __builtin_amdgcn_rcpf(E3); const float q = e ? bf_hi(qc[i]) : bf_lo(qc[i]);
                                qr[e] = q * (E3 * rmid[e]); bl[i8][e] = kv * (emid[e] * rE); }
                            const int po = ((16 * pw + i) * SQ + 2 * cp) * 2;
                            *(LAS unsigned*)(lds + base + B_QR + po) = pk2(qr[0], qr[1]); *(LAS unsigned*)(lds + base + B_KR + po) = pk2(bl[i8][0], bl[i8][1]);
                        }
#pragma unroll
                        for (int e = 0; e < 2; ++e) { v4u t; t.x = pk2(bl[0][e], bl[1][e]); t.y = pk2(bl[2][e], bl[3][e]); t.z = pk2(bl[4][e], bl[5][e]); t.w = pk2(bl[6][e], bl[7][e]);
                            *(LAS v4u*)(lds + base + B_KRT + ((2 * cp + e) * SK + 16 * pw + 8 * hf) * 2) = t; }
                    }
#pragma unroll
                    for (int e = 0; e < 2; ++e) { v4u t;
                        if (e == 0) { t.x = (vc[0] & 0xffffu) | (vc[1] << 16); t.y = (vc[2] & 0xffffu) | (vc[3] << 16); t.z = (vc[4] & 0xffffu) | (vc[5] << 16); t.w = (vc[6] & 0xffffu) | (vc[7] << 16); }
                        else { t.x = (vc[0] >> 16) | (vc[1] & 0xffff0000u); t.y = (vc[2] >> 16) | (vc[3] & 0xffff0000u); t.z = (vc[4] >> 16) | (vc[5] & 0xffff0000u); t.w = (vc[6] >> 16) | (vc[7] & 0xffff0000u); }
                        *(LAS v4u*)(lds + base + B_VT + ((2 * vcp + e) * SK + 8 * sseg) * 2) = t; }
                    if (pw == 0) { f32x2 t; t.x = emid[0]; t.y = emid[1]; *(LAS f32x2*)(lds + ch + (2 * cp) * 4) = t; t.x = elast[0]; t.y = elast[1]; *(LAS f32x2*)(lds + ch + 512 + (2 * cp) * 4) = t;
                        t.x = elast[0] * rmid[0]; t.y = elast[1] * rmid[1]; *(LAS f32x2*)(lds + ch + 1024 + (2 * cp) * 4) = t; }
                }
            } else if (step >= 0) {
                const int base = (step & 1) * BUF_SZ, t0 = 16 * cw;
                f32x4 ao[4];
#pragma unroll
                for (int nt = 0; nt < 4; ++nt) ao[nt] = (f32x4){0.f, 0.f, 0.f, 0.f};
#pragma unroll
                for (int ks = 0; ks < 4; ++ks) { const bf16x8 bq = frag(lds, base + B_QR, t0, ks, SQ, fr, fq);
#pragma unroll
                    for (int nt = 0; nt < 4; ++nt) ao[nt] = MFMA16(frag(lds, P2_ST, 16 * nt, ks, SQ, fr, fq), bq, ao[nt]); }
#pragma unroll
                for (int ks = 0; ks < 2; ++ks) if (ks == 0 || cw >= 2) { const bf16x8 bp = frag(lds, P2_P, t0, ks, SK, fr, fq);
#pragma unroll
                    for (int nt = 0; nt < 4; ++nt) ao[nt] = MFMA16(frag(lds, base + B_VT, 16 * nt, ks, SK, fr, fq), bp, ao[nt]); }
                const int j = t0 + fr; const int tok = dir ? (tokbase + 64 * (31 - step) + 63 - j) : (tokbase + 64 * step + j);
#pragma unroll
                for (int nt = 0; nt < 4; ++nt) *(f32x4*)(ob + (size_t)tok * 2048 + 16 * nt + 4 * fq) = ao[nt];
            }
            LBAR();
        }
    }
}

__device__ __forceinline__ void unpack8(const v4u u, float (&f)[8]) { f[0] = bf_lo(u.x); f[1] = bf_hi(u.x); f[2] = bf_lo(u.y); f[3] = bf_hi(u.y); f[4] = bf_lo(u.z); f[5] = bf_hi(u.z); f[6] = bf_lo(u.w); f[7] = bf_hi(u.w); }
__device__ __forceinline__ void conv_y(const bf16_t* proj, const float* cw, int row, int e0, bool hasp, bool hasn, float (&y)[8]) {
    const size_t off = (size_t)row * 2048 + e0;
    float bg[8], c0[8], h0[8], cm[8], hm[8], cn[8], hn[8];
    unpack8(*(const v4u*)(proj + 5 * SECN + off), bg); unpack8(*(const v4u*)(proj + 6 * SECN + off), c0); unpack8(*(const v4u*)(proj + 7 * SECN + off), h0);
    v4u zz; zz.x = 0u; zz.y = 0u; zz.z = 0u; zz.w = 0u;
    unpack8(hasp ? *(const v4u*)(proj + 6 * SECN + off - 2048) : zz, cm); unpack8(hasp ? *(const v4u*)(proj + 7 * SECN + off - 2048) : zz, hm);
    unpack8(hasn ? *(const v4u*)(proj + 6 * SECN + off + 2048) : zz, cn); unpack8(hasn ? *(const v4u*)(proj + 7 * SECN + off + 2048) : zz, hn);
    const f32x4 w00 = *(const f32x4*)(cw + e0), w01 = *(const f32x4*)(cw + e0 + 4), w10 = *(const f32x4*)(cw + 2048 + e0), w11 = *(const f32x4*)(cw + 2048 + e0 + 4), w20 = *(const f32x4*)(cw + 4096 + e0), w21 = *(const f32x4*)(cw + 4096 + e0 + 4);
#pragma unroll
    for (int j = 0; j < 8; ++j) { const float wa = j < 4 ? w00[j] : w01[j - 4], wb = j < 4 ? w10[j] : w11[j - 4], wc = j < 4 ? w20[j] : w21[j - 4];
        y[j] = bg[j] * (wa * (cm[j] * hm[j]) + wb * (c0[j] * h0[j]) + wc * (cn[j] * hn[j])); }
}
__device__ __forceinline__ void mix_phase(const Args& a, int bid, int nblk) {
    const int lane = threadIdx.x & 63, w = threadIdx.x >> 6;
    const int gw = bid * 8 + w, NGW = nblk * 8;
    const bf16_t* proj = (const bf16_t*)(a.ws + WS_PROJ);
    const float* OF = (const float*)(a.ws + WS_OF); const float* OB = OF + SECN;
    const float* hw = a.in[5]; const float* cw = a.in[6]; const float* cnw = a.in[7];
    bf16_t* cat = (bf16_t*)(a.ws + WS_CAT);
    for (int row = gw; row < MTOK; row += NGW) {
        const int t = row & (SEQL - 1);
        const bool hasp = t > 0, hasn = t < SEQL - 1;
#pragma unroll 1
        for (int ps = 0; ps < 4; ++ps) {
            const int e0 = ps * 512 + lane * 8; const size_t off = (size_t)row * 2048 + e0;
            const f32x4 a0 = *(const f32x4*)(OF + off), a1 = *(const f32x4*)(OF + off + 4), b0 = *(const f32x4*)(OB + off), b1 = *(const f32x4*)(OB + off + 4);
            float o[8]; float ss = 0.f;
#pragma unroll
            for (int j = 0; j < 4; ++j) { o[j] = a0[j] + b0[j]; o[4 + j] = a1[j] + b1[j]; }
#pragma unroll
            for (int j = 0; j < 8; ++j) ss += o[j] * o[j];
            ss += __shfl_xor(ss, 1); ss += __shfl_xor(ss, 2); ss += __shfl_xor(ss, 4); ss += __shfl_xor(ss, 8);
            const float rstd = __builtin_amdgcn_rsqf(ss * (1.f / 128.f) + EPSV);
            float z[8]; unpack8(*(const v4u*)(proj + 4 * SECN + off), z);
            const f32x4 g0 = *(const f32x4*)(hw + e0), g1 = *(const f32x4*)(hw + e0 + 4);
            float r[8];
#pragma unroll
            for (int j = 0; j < 8; ++j) r[j] = o[j] * rstd * (j < 4 ? g0[j] : g1[j - 4]) * z[j] * sigm(z[j]);
            v4u q; q.x = pk2(r[0], r[1]); q.y = pk2(r[2], r[3]); q.z = pk2(r[4], r[5]); q.w = pk2(r[6], r[7]);
            *(v4u*)(cat + (size_t)row * 4096 + e0) = q;
        }
        float ss = 0.f; unsigned yp[4][4];
#pragma unroll
        for (int ps = 0; ps < 4; ++ps) { float y[8]; __builtin_amdgcn_sched_barrier(0); conv_y(proj, cw, row, ps * 512 + lane * 8, hasp, hasn, y);
#pragma unroll
            for (int j = 0; j < 8; ++j) ss += y[j] * y[j];
#pragma unroll
            for (int j = 0; j < 4; ++j) yp[ps][j] = pk2(y[2 * j], y[2 * j + 1]); }
        const float rstd = __builtin_amdgcn_rsqf(wave_sum(ss) * (1.f / 2048.f) + EPSV);
#pragma unroll
        for (int ps = 0; ps < 4; ++ps) {
            const int e0 = ps * 512 + lane * 8; const size_t off = (size_t)row * 2048 + e0;
            float y[8]; { v4u t; t.x = yp[ps][0]; t.y = yp[ps][1]; t.z = yp[ps][2]; t.w = yp[ps][3]; unpack8(t, y); }
            float z[8]; unpack8(*(const v4u*)(proj + 8 * SECN + off), z);
            const f32x4 g0 = *(const f32x4*)(cnw + e0), g1 = *(const f32x4*)(cnw + e0 + 4);
            float r[8];
#pragma unroll
            for (int j = 0; j < 8; ++j) r[j] = y[j] * rstd * (j < 4 ? g0[j] : g1[j - 4]) * z[j] * sigm(z[j]);
            v4u q; q.x = pk2(r[0], r[1]); q.y = pk2(r[2], r[3]); q.z = pk2(r[4], r[5]); q.w = pk2(r[6], r[7]);
            *(v4u*)(cat + (size_t)row * 4096 + 2048 + e0) = q;
        }
    }
}

__device__ __forceinline__ void final_phase(const Args& a, int bid, int nblk) {
    const int lane = threadIdx.x & 63, w = threadIdx.x >> 6;
    const int gw = bid * 8 + w, NGW = nblk * 8;
    const float* part = (const float*)(a.ws + WS_PART); const float* fw = a.in[11];
    for (int row = gw; row < MTOK; row += NGW) {
        const float ps = lane < 32 ? part[(size_t)row * 32 + lane] : 0.f;
        const float rstd = __builtin_amdgcn_rsqf(wave_sum(ps) * (1.f / 2048.f) + EPSV);
        f32x4* o = (f32x4*)(a.out + (size_t)row * 2048) + lane;
#pragma unroll
        for (int j = 0; j < 8; ++j) { const f32x4 g = *((const f32x4*)fw + lane + 64 * j); f32x4 v = o[64 * j]; v.x *= rstd * g.x; v.y *= rstd * g.y; v.z *= rstd * g.z; v.w *= rstd * g.w; o[64 * j] = v; }
    }
}

#define RLX_AGENT __ATOMIC_RELAXED, __HIP_MEMORY_SCOPE_AGENT
#define XB_TMO      128
#define XB_XCNT(j)  (256  + 64 * (j))
#define XB_XSUB(j)  (1280 + 64 * (j))
#define XB_XGEN(j)  (2304 + 64 * (j))
#define XB_TOP      3328
#define XB_TOPGEN   3392
#define XCD_BAR_WORDS 3456
#define XB_SPIN_CAP (1u << 18)

__device__ __forceinline__ unsigned xb_ld(unsigned* p)              { return __hip_atomic_load(p, __ATOMIC_RELAXED, __HIP_MEMORY_SCOPE_AGENT); }
__device__ __forceinline__ unsigned xb_add(unsigned* p, unsigned v) { return __hip_atomic_fetch_add(p, v, __ATOMIC_RELAXED, __HIP_MEMORY_SCOPE_AGENT); }
__device__ __forceinline__ unsigned xb_xcc_id() { return (unsigned)__builtin_amdgcn_s_getreg((3 << 11) | 20) & 0xFu; }
#define XB_SPIN(cond, bar) do { unsigned _sp = 0; while (cond) { __builtin_amdgcn_s_sleep(1); \
    if ((++_sp & 255u) == 0u) { if (xb_ld(&(bar)[XB_TMO])) break; if (_sp > XB_SPIN_CAP) { atomicAdd(&(bar)[XB_TMO], 1u); break; } } } } while (0)

struct XcdBarrier {
    unsigned* bar; unsigned x;
    volatile LAS unsigned* st;
};

__device__ __forceinline__ XcdBarrier xcd_barrier_post(unsigned* bar, volatile LAS unsigned* st) {
    XcdBarrier b; b.bar = bar; b.x = xb_xcc_id(); b.st = st;
    if (threadIdx.x == 0) (void)xb_add(&bar[XB_XCNT(b.x)], 1u);
    return b;
}
__device__ __forceinline__ void xcd_barrier_complete(unsigned* bar, unsigned x, unsigned& nloc, unsigned& nx) {
    const unsigned G = gridDim.x * gridDim.y * gridDim.z;
    unsigned sum, cnt, mine, sp = 0u;
    for (;;) {
        sum = 0u; cnt = 0u; mine = 0u;
#pragma unroll
        for (unsigned j = 0; j < 16; ++j) { const unsigned c = xb_ld(&bar[XB_XCNT(j)]); sum += c; cnt += (c > 0u) ? 1u : 0u; mine = (j == x) ? c : mine; }
        if (sum == G) break;
        __builtin_amdgcn_s_sleep(1);
        if ((++sp & 255u) == 0u) { if (xb_ld(&bar[XB_TMO])) break; if (sp > XB_SPIN_CAP) { atomicAdd(&bar[XB_TMO], 1u); break; } }
    }
    nloc = mine > 0u ? mine : 1u; nx = cnt > 0u ? cnt : 1u;
}

__device__ __forceinline__ void xcd_barrier(const XcdBarrier& b) {
    asm volatile("s_waitcnt vmcnt(0)" ::: "memory");
    __syncthreads();
    if (threadIdx.x == 0) {
        unsigned* bar = b.bar;
        __builtin_amdgcn_s_waitcnt(0);
        unsigned nloc = b.st[0], nx = b.st[1];
        if (nloc == 0u) { xcd_barrier_complete(bar, b.x, nloc, nx); b.st[0] = nloc; b.st[1] = nx; }
        const unsigned old = xb_add(&bar[XB_XSUB(b.x)], 1u);
        const unsigned gen = old / nloc;
        if (old + 1u == (gen + 1u) * nloc) {
            __builtin_amdgcn_fence(__ATOMIC_RELEASE, "agent");
            asm volatile("s_waitcnt vmcnt(0)" ::: "memory");
            const unsigned og = xb_add(&bar[XB_TOP], 1u);
            const unsigned tg = og / nx;
            if (og + 1u == (tg + 1u) * nx) xb_add(&bar[XB_TOPGEN], 1u);
            else XB_SPIN(xb_ld(&bar[XB_TOPGEN]) == tg, bar);
            __builtin_amdgcn_fence(__ATOMIC_ACQUIRE, "agent");
            xb_add(&bar[XB_XGEN(b.x)], 1u);
            asm volatile("s_waitcnt vmcnt(0)" ::: "memory");
        } else {
            XB_SPIN(xb_ld(&bar[XB_XGEN(b.x)]) == gen, bar);
            __builtin_amdgcn_fence(__ATOMIC_ACQUIRE, "agent");
            asm volatile("s_waitcnt vmcnt(0)" ::: "memory");
        }
    }
    __syncthreads();
}

constexpr int NPHASE = 7;
__global__ void __launch_bounds__(512, 2) hymba_fwd(Args a) {
    extern __shared__ __attribute__((aligned(16))) unsigned char shm[];
    LAS unsigned char* lds = (LAS unsigned char*)shm;
    cg::grid_group grid = cg::this_grid();
    const int bid = blockIdx.x, nblk = gridDim.x;
    unsigned char* ws = a.ws;
#if MK_LAUNCHES == 1
    if (threadIdx.x < 16) ((volatile LAS unsigned*)(lds + MISC_OFF))[threadIdx.x] = 0u;
    __syncthreads();
    XcdBarrier bar = xcd_barrier_post((unsigned*)(ws + WS_CTL), (volatile LAS unsigned*)(lds + MISC_OFF));
    if (a.ph_hi == 0x7fffffff) grid.sync();
#define IN(k) true
#define SEAM() xcd_barrier(bar)
#else
    const int lo = a.ph_lo, hi = a.ph_hi;
#define IN(k) (lo <= (k) && (k) < hi)
#define SEAM() do {} while (0)
#endif
    if (IN(0)) { if (PHM & 1) prep_phase(lds, a, bid, nblk); SEAM(); if (REP & 1) { prep_phase(lds, a, bid, nblk); SEAM(); } }
    if (IN(1)) { if (PHM & 2) {
            pg8::Gemm g; g.A = (const bf16_t*)(ws + WS_HN); g.Bt = (const bf16_t*)(ws + WS_WIN); g.M = MTOK; g.N = NIN; g.K = DM;
            pg8::StaticOrder S; S.init(g.M, g.N, nblk, bid); pg8::EpiProj E; E.O = (bf16_t*)(ws + WS_PROJ); E.LBO = a.in[4];
            pg8::gemm_phase<pg8::EpiProj, pg8::StaticOrder, true, true>(lds, g, S, E); }
        SEAM(); }
    if (REP & 2) { if (PHM & 2) {
            pg8::Gemm g; g.A = (const bf16_t*)(ws + WS_HN); g.Bt = (const bf16_t*)(ws + WS_WIN); g.M = MTOK; g.N = NIN; g.K = DM;
            pg8::StaticOrder S; S.init(g.M, g.N, nblk, bid); pg8::EpiProj E; E.O = (bf16_t*)(ws + WS_PROJ); E.LBO = a.in[4];
            pg8::gemm_phase<pg8::EpiProj, pg8::StaticOrder, true, true>(lds, g, S, E); }
        SEAM(); }
    if (IN(2)) { if (PHM & 4) hgrn_phase(lds, a, bid, nblk); SEAM(); if (REP & 4) { hgrn_phase(lds, a, bid, nblk); SEAM(); } }
    if (IN(3)) { if (PHM & 8) mix_phase(a, bid, nblk); SEAM(); if (REP & 8) { mix_phase(a, bid, nblk); SEAM(); } }
    if (IN(4)) { if (PHM & 16) {
            pg8::Gemm g; g.A = (const bf16_t*)(ws + WS_CAT); g.Bt = (const bf16_t*)(ws + WS_WOUT); g.M = MTOK; g.N = DM; g.K = DMIX;
            pg8::StaticOrder S; S.init(g.M, g.N, nblk, bid); pg8::EpiH E; E.X = a.in[0]; E.H = (float*)(ws + WS_H); E.HB = (bf16_t*)(ws + WS_HB);
            pg8::gemm_phase<pg8::EpiH, pg8::StaticOrder, false, true>(lds, g, S, E); }
        SEAM(); }
    if (REP & 16) { if (PHM & 16) {
            pg8::Gemm g; g.A = (const bf16_t*)(ws + WS_CAT); g.Bt = (const bf16_t*)(ws + WS_WOUT); g.M = MTOK; g.N = DM; g.K = DMIX;
            pg8::StaticOrder S; S.init(g.M, g.N, nblk, bid); pg8::EpiH E; E.X = a.in[0]; E.H = (float*)(ws + WS_H); E.HB = (bf16_t*)(ws + WS_HB);
            pg8::gemm_phase<pg8::EpiH, pg8::StaticOrder, false, true>(lds, g, S, E); }
        SEAM(); }
    if (IN(5)) {
        if (PHM & 32) {   pg8::Gemm g; g.A = (const bf16_t*)(ws + WS_PB); g.Bt = (const bf16_t*)(ws + WS_WP); g.M = MTOK; g.N = DM; g.K = PLED;
            pg8::StaticOrder S; S.init(g.M, g.N, nblk, bid); pg8::EpiPle E; E.O = (bf16_t*)(ws + WS_OF);
            pg8::gemm_phase<pg8::EpiPle, pg8::StaticOrder, false, true>(lds, g, S, E); }
        if (PHM & 64) {   pg8::Gemm g; g.A = (const bf16_t*)(ws + WS_HB); g.Bt = (const bf16_t*)(ws + WS_WG); g.M = MTOK; g.N = DM; g.K = DM;
            pg8::StaticOrder S; S.init(g.M, g.N, nblk, bid); pg8::EpiGate E; E.H = (const float*)(ws + WS_H); E.PL = (const bf16_t*)(ws + WS_OF); E.O = a.out; E.PART = (float*)(ws + WS_PART);
            pg8::gemm_phase<pg8::EpiGate, pg8::StaticOrder, false, true>(lds, g, S, E); }
        SEAM(); }
    if (IN(6)) { if (PHM & 128) final_phase(a, bid, nblk); }
}

extern "C" void kernel_launch(void* const* d_in, const int* in_sizes, int n_in, void* d_out, int out_size, void* d_ws, size_t ws_size, hipStream_t stream) {
    static int grid = 0;
    if (grid == 0) {
        if (n_in != 12 || out_size != MTOK * DM || ws_size < WS_END) { fprintf(stderr, "kernel_launch: unexpected shapes (n_in %d out %d ws %zu)\n", n_in, out_size, ws_size); grid = -1; return; }
        int dev = 0, cus = 0, per_cu = 0;
        hipGetDevice(&dev); hipDeviceGetAttribute(&cus, hipDeviceAttributeMultiprocessorCount, dev);
        if (hipFuncSetAttribute((const void*)hymba_fwd, hipFuncAttributeMaxDynamicSharedMemorySize, LDS_BYTES) != hipSuccess) { fprintf(stderr, "kernel_launch: hipFuncSetAttribute failed\n"); grid = -1; return; }
        if (hipOccupancyMaxActiveBlocksPerMultiprocessor(&per_cu, (const void*)hymba_fwd, 512, LDS_BYTES) != hipSuccess || per_cu < 1) { fprintf(stderr, "kernel_launch: occupancy query failed (%d)\n", per_cu); (void)hipGetLastError(); per_cu = 1; }
        grid = cus * (per_cu > 1 ? 1 : per_cu);
        if (grid <= 0) grid = 256;
    }
    if (grid < 0) return;
    Args a{};
    if (hipMemsetAsync((char*)d_ws + WS_CTL, 0, XCD_BAR_WORDS * 4, stream) != hipSuccess) { fprintf(stderr, "kernel_launch: memset failed\n"); return; }
    for (int i = 0; i < 12; ++i) a.in[i] = (const float*)d_in[i];
    a.out = (float*)d_out; a.ws = (unsigned char*)d_ws;
#if MK_LAUNCHES == 1
    a.ph_lo = 0; a.ph_hi = NPHASE;
    void* args[] = {&a};
    hipError_t e = hipLaunchCooperativeKernel((const void*)hymba_fwd, dim3(grid), dim3(512), args, LDS_BYTES, stream);
    if (e != hipSuccess) fprintf(stderr, "cooperative launch failed: %s (grid %d)\n", hipGetErrorString(e), grid);
#else
    for (int ph = 0; ph < NPHASE; ++ph) { a.ph_lo = ph; a.ph_hi = ph + 1; hipLaunchKernelGGL(hymba_fwd, dim3(grid), dim3(512), LDS_BYTES, stream, a); }
#endif
}
```

```cpp
#include <hip/hip_runtime.h>
#include <hip/hip_cooperative_groups.h>
#include <cstdio>
#include <cstdint>
namespace cg = cooperative_groups;
#ifndef TSPH
#define TSPH -1
#endif
#ifndef REP
#define REP 0
#endif
#ifndef PHM
#define PHM 255
#endif
#ifndef MK_LAUNCHES
#define MK_LAUNCHES 1
#endif
namespace pg8 {
#define PG8_LAS __attribute__((address_space(3)))
typedef unsigned short bf16_t;
typedef short bf16x8 __attribute__((ext_vector_type(8)));
typedef float f32x4 __attribute__((ext_vector_type(4)));
typedef unsigned u32x4 __attribute__((ext_vector_type(4)));
constexpr int BM = 256, BK = 64, HALF = 128, HTB = HALF * BK * 2  , STAGE_BYTES = 8 * HTB, NXCD = 8, WGM = 8;

__host__ __device__ __forceinline__ int lds_byte(int r, int c) { const int st = (r >> 4) * 2 + (c >> 5), rr = r & 15, cc = c & 31, ob = rr * 64 + cc * 2; return st * 1024 + (ob ^ (((ob >> 9) & 1) << 5)); }
__host__ __device__ __forceinline__ void stage_rc(int b, int& R, int& C) { const int st = b / 1024, sb = b % 1024, swz = sb ^ (((sb >> 9) & 1) << 5); R = (st >> 1) * 16 + swz / 64; C = (st & 1) * 32 + (swz % 64) / 2; }
__host__ __device__ __forceinline__ int perm32(int rho) { const int n = rho >> 4, i = rho & 15; return 8 * (i >> 2) + 4 * n + (i & 3); }

struct Unit { int pm, pn; };
struct Gemm { const bf16_t* A; const bf16_t* Bt; int M, N, K; };

struct StaticOrder {
    int nM, nN, nwg, G, c;
    __host__ __device__ void init(int M, int N, int G_, int c_) { nM = M / BM; nN = N / BM; nwg = nM * nN; G = G_; c = c_; }
    __host__ __device__ bool next(int i, Unit& u) const {
        const long L = (long)i * G + c; if (L >= nwg) return false;
        int wgid = (int)L; { const int q = nwg / NXCD, r = nwg % NXCD, xcd = wgid % NXCD, off = wgid / NXCD; wgid = (xcd < r ? xcd * (q + 1) : r * (q + 1) + (xcd - r) * q) + off; }
        const int nig = WGM * nN, gid = wgid / nig, fm = gid * WGM, gsz = (nM - fm) < WGM ? (nM - fm) : WGM;
        u.pm = fm + ((wgid % nig) % gsz); u.pn = (wgid % nig) / gsz; return true;
    }
    __device__ __forceinline__ void a_ready(const Unit&) const {}
    __device__ __forceinline__ void done(const Unit&) const {}
};

typedef __bf16 bf16x2n_t __attribute__((ext_vector_type(2)));
typedef float f32x2n_t __attribute__((ext_vector_type(2)));
__device__ __forceinline__ unsigned cvt_pk_bf16(float lo, float hi) { f32x2n_t v; v.x = lo; v.y = hi; const bf16x2n_t r = __builtin_convertvector(v, bf16x2n_t); return __builtin_bit_cast(unsigned, r); }
typedef float f32x2 __attribute__((ext_vector_type(2)));
__device__ __forceinline__ float sigmoidf_fast(float v) { return __builtin_amdgcn_rcpf(1.0f + __builtin_amdgcn_exp2f(-1.44269504f * v)); }

constexpr size_t SECN = (size_t)8192 * 2048;
struct EpiProj {
    static constexpr bool PERM = true, AFTER_DRAIN = false;
    bf16_t* O; const float* LBO;
    __device__ __forceinline__ void operator()(const f32x4 (&acc)[2][2][4][2], const Unit& u, int wr, int wc, int fr, int fq) const {
        const int row0 = u.pm * BM + wr * 64 + fr; int colt = u.pn * BM; const int sec = colt >> 11; colt -= sec << 11;
        if (sec == 6 || sec == 7) {
            bf16_t* ub = O + (size_t)6 * SECN + (u.pn - 48) * 128 + wc * 32 + 8 * fq;
#pragma unroll
            for (int ai = 0; ai < 2; ++ai)
#pragma unroll
                for (int m = 0; m < 4; ++m) { const f32x4 v0 = acc[ai][0][m][0] * acc[ai][1][m][0], v1 = acc[ai][0][m][1] * acc[ai][1][m][1];
                    u32x4 w; w.x = cvt_pk_bf16(v0[0], v0[1]); w.y = cvt_pk_bf16(v0[2], v0[3]); w.z = cvt_pk_bf16(v1[0], v1[1]); w.w = cvt_pk_bf16(v1[2], v1[3]);
                    *(u32x4*)(ub + (size_t)(row0 + ai * HALF + m * 16) * 2048) = w; }
            return; }
        bf16_t* base = O + (size_t)sec * SECN; const int col0 = colt + wc * 32 + 8 * fq;
        f32x4 oml[2][2];
#pragma unroll
        for (int bj = 0; bj < 2; ++bj)
#pragma unroll
            for (int n = 0; n < 2; ++n) { oml[bj][n] = (f32x4){0.f, 0.f, 0.f, 0.f};
                if (sec == 2 || sec == 3) { const float* tp = LBO + (sec - 2) * 4096 + col0 + bj * HALF + 4 * n; const f32x4 t0 = *(const f32x4*)(tp), t1 = *(const f32x4*)(tp + 2048);
#pragma unroll
                    for (int j = 0; j < 4; ++j) oml[bj][n][j] = sigmoidf_fast(t1[j] - t0[j]); } }
#pragma unroll
        for (int ai = 0; ai < 2; ++ai)
#pragma unroll
            for (int m = 0; m < 4; ++m) { const int r = row0 + ai * HALF + m * 16; bf16_t* rowp = base + (unsigned)(r * 2048 + col0);
                bf16_t* hrow = base + (unsigned)((((r >> 11) * 16 + (colt >> 7)) * 2048 + (r & 2047)) * 128 + wc * 32 + 8 * fq);
#pragma unroll
                for (int bj = 0; bj < 2; ++bj) { f32x4 v0 = acc[ai][bj][m][0], v1 = acc[ai][bj][m][1];
                    if (sec == 0) {
#pragma unroll
                        for (int j = 0; j < 4; ++j) { v0[j] = v0[j] * sigmoidf_fast(v0[j]); v1[j] = v1[j] * sigmoidf_fast(v1[j]); } }
                    if (sec == 2 || sec == 3) {
#pragma unroll
                        for (int j = 0; j < 4; ++j) { v0[j] = oml[bj][0][j] * sigmoidf_fast(-v0[j]); v1[j] = oml[bj][1][j] * sigmoidf_fast(-v1[j]); } }
                    u32x4 w; w.x = cvt_pk_bf16(v0[0], v0[1]); w.y = cvt_pk_bf16(v0[2], v0[3]); w.z = cvt_pk_bf16(v1[0], v1[1]); w.w = cvt_pk_bf16(v1[2], v1[3]);
                    if (sec < 4) *(u32x4*)(hrow + (size_t)bj * 2048 * 128) = w; else *(u32x4*)(rowp + bj * HALF) = w; } }
    }
};
struct EpiH {
    static constexpr bool PERM = true, AFTER_DRAIN = false;
    const float* X; float* H; bf16_t* HB;
    __device__ __forceinline__ void operator()(const f32x4 (&acc)[2][2][4][2], const Unit& u, int wr, int wc, int fr, int fq) const {
        const int row0 = u.pm * BM + wr * 64 + fr; const int col0 = u.pn * BM + wc * 32 + 8 * fq;
#pragma unroll
        for (int ai = 0; ai < 2; ++ai)
#pragma unroll
            for (int m = 0; m < 4; ++m) { const size_t off = (size_t)(row0 + ai * HALF + m * 16) * 2048 + col0;
#pragma unroll
                for (int bj = 0; bj < 2; ++bj) { const f32x4 x0 = __builtin_nontemporal_load((const f32x4*)(X + off + bj * HALF)), x1 = __builtin_nontemporal_load((const f32x4*)(X + off + bj * HALF + 4));
                    const f32x4 v0 = acc[ai][bj][m][0] + x0, v1 = acc[ai][bj][m][1] + x1;
                    u32x4 w; w.x = cvt_pk_bf16(v0[0], v0[1]); w.y = cvt_pk_bf16(v0[2], v0[3]); w.z = cvt_pk_bf16(v1[0], v1[1]); w.w = cvt_pk_bf16(v1[2], v1[3]);
                    *(u32x4*)(HB + off + bj * HALF) = w; } }
    }
};
struct EpiPle {
    static constexpr bool PERM = true, AFTER_DRAIN = false;
    bf16_t* O;
    __device__ __forceinline__ void operator()(const f32x4 (&acc)[2][2][4][2], const Unit& u, int wr, int wc, int fr, int fq) const {
        const int row0 = u.pm * BM + wr * 64 + fr; const int col0 = u.pn * BM + wc * 32 + 8 * fq;
#pragma unroll
        for (int ai = 0; ai < 2; ++ai)
#pragma unroll
            for (int m = 0; m < 4; ++m) { const size_t off = (size_t)(row0 + ai * HALF + m * 16) * 2048 + col0;
#pragma unroll
                for (int bj = 0; bj < 2; ++bj) { const f32x4 v0 = acc[ai][bj][m][0], v1 = acc[ai][bj][m][1];
                    u32x4 w; w.x = cvt_pk_bf16(v0[0], v0[1]); w.y = cvt_pk_bf16(v0[2], v0[3]); w.z = cvt_pk_bf16(v1[0], v1[1]); w.w = cvt_pk_bf16(v1[2], v1[3]);
                    *(u32x4*)(O + off + bj * HALF) = w; } }
    }
};
struct EpiGateNorm {
    static constexpr bool PERM = true, AFTER_DRAIN = true;
    const bf16_t* HBF; const bf16_t* PL; float* O; float* XS; unsigned* CNT; const float* FW;
    __device__ __forceinline__ void operator()(const f32x4 (&)[2][2][4][2], const Unit&, int, int, int, int) const {}
    __device__ __forceinline__ void fused(f32x4 (&acc)[2][2][4][2], const Unit& u, int wr, int wc, int fr, int fq, PG8_LAS unsigned char* lds, int wid, int lane) const {
        PG8_LAS float* PS = (PG8_LAS float*)lds; PG8_LAS float* RS = (PG8_LAS float*)(lds + 4096);
        const int row0 = u.pm * BM + wr * 64 + fr; const int col0 = u.pn * BM + wc * 32 + 8 * fq;
#pragma unroll
        for (int ai = 0; ai < 2; ++ai)
#pragma unroll
            for (int m = 0; m < 4; ++m) { const int row = row0 + ai * HALF + m * 16; const size_t off = (size_t)row * 2048 + col0; float ss = 0.f;
#pragma unroll
                for (int bj = 0; bj < 2; ++bj) {
                    const u32x4 hw = *(const u32x4*)(HBF + off + bj * HALF);
                    const f32x4 h0 = (f32x4){__uint_as_float(hw.x << 16), __uint_as_float(hw.x & 0xffff0000u), __uint_as_float(hw.y << 16), __uint_as_float(hw.y & 0xffff0000u)};
                    const f32x4 h1 = (f32x4){__uint_as_float(hw.z << 16), __uint_as_float(hw.z & 0xffff0000u), __uint_as_float(hw.w << 16), __uint_as_float(hw.w & 0xffff0000u)};
                    const u32x4 pw = *(const u32x4*)(PL + off + bj * HALF);
                    const f32x4 p0 = (f32x4){__uint_as_float(pw.x << 16), __uint_as_float(pw.x & 0xffff0000u), __uint_as_float(pw.y << 16), __uint_as_float(pw.y & 0xffff0000u)};
                    const f32x4 p1 = (f32x4){__uint_as_float(pw.z << 16), __uint_as_float(pw.z & 0xffff0000u), __uint_as_float(pw.w << 16), __uint_as_float(pw.w & 0xffff0000u)};
                    f32x4 v0, v1;
#pragma unroll
                    for (int j = 0; j < 4; ++j) { v0[j] = h0[j] + p0[j] * sigmoidf_fast(acc[ai][bj][m][0][j]); v1[j] = h1[j] + p1[j] * sigmoidf_fast(acc[ai][bj][m][1][j]);
                        ss += v0[j] * v0[j] + v1[j] * v1[j]; }
                    acc[ai][bj][m][0] = v0; acc[ai][bj][m][1] = v1; }
                ss += __shfl_xor(ss, 16); ss += __shfl_xor(ss, 32);
                if (fq == 0) PS[(ai * HALF + wr * 64 + m * 16 + fr) * 4 + wc] = ss; }
        asm volatile("s_waitcnt lgkmcnt(0)" ::: "memory"); __builtin_amdgcn_s_barrier(); asm volatile("" ::: "memory");
        const int tid = wid * 64 + lane;
        if (tid < 256) { const f32x4 p = *(const PG8_LAS f32x4*)(PS + tid * 4);
            __hip_atomic_store(XS + (size_t)(u.pm * 256 + tid) * 8 + u.pn, (p[0] + p[1]) + (p[2] + p[3]), __ATOMIC_RELAXED, __HIP_MEMORY_SCOPE_AGENT); }
        asm volatile("s_waitcnt vmcnt(0)" ::: "memory"); __builtin_amdgcn_s_barrier(); asm volatile("" ::: "memory");
        if (tid == 0) { unsigned* c = CNT + 64 * u.pm; __hip_atomic_fetch_add(c, 1u, __ATOMIC_RELAXED, __HIP_MEMORY_SCOPE_AGENT);
            unsigned sp = 0; while (__hip_atomic_load(c, __ATOMIC_RELAXED, __HIP_MEMORY_SCOPE_AGENT) < 8u) { __builtin_amdgcn_s_sleep(1); if (++sp > (1u << 20)) break; } }
        asm volatile("" ::: "memory"); __builtin_amdgcn_s_barrier(); asm volatile("" ::: "memory");
        if (tid < 256) { const float* x = XS + (size_t)(u.pm * 256 + tid) * 8; float s = 0.f;
#pragma unroll
            for (int k = 0; k < 8; ++k) s += __hip_atomic_load(x + k, __ATOMIC_RELAXED, __HIP_MEMORY_SCOPE_AGENT);
            RS[tid] = __builtin_amdgcn_rsqf(s * (1.f / 2048.f) + 1e-6f); }
        asm volatile("s_waitcnt lgkmcnt(0)" ::: "memory"); __builtin_amdgcn_s_barrier(); asm volatile("" ::: "memory");
        f32x4 fw[2][2];
#pragma unroll
        for (int bj = 0; bj < 2; ++bj) { fw[bj][0] = *(const f32x4*)(FW + col0 + bj * HALF); fw[bj][1] = *(const f32x4*)(FW + col0 + bj * HALF + 4); }
#pragma unroll
        for (int ai = 0; ai < 2; ++ai)
#pragma unroll
            for (int m = 0; m < 4; ++m) { const int rl = ai * HALF + wr * 64 + m * 16 + fr; const float rstd = RS[rl]; const size_t off = (size_t)(u.pm * BM + rl) * 2048 + col0;
#pragma unroll
                for (int bj = 0; bj < 2; ++bj) { __builtin_nontemporal_store(acc[ai][bj][m][0] * rstd * fw[bj][0], (f32x4*)(O + off + bj * HALF)); __builtin_nontemporal_store(acc[ai][bj][m][1] * rstd * fw[bj][1], (f32x4*)(O + off + bj * HALF + 4)); } }
    }
};

template <class Epi, class Sched, bool ALIGN_EPI = false, bool SP2 = false>
__device__ __forceinline__ void gemm_phase(PG8_LAS unsigned char* lds, const Gemm g, const Sched& S, const Epi& E) {
    int tid_ = threadIdx.x; asm volatile("" : "+v"(tid_));
    const int tid = tid_, wid = __builtin_amdgcn_readfirstlane(tid >> 6), lane = tid & 63, wr = wid >> 2, wc = wid & 3, fr = lane & 15, fq = lane >> 4;
    const int K = g.K, nt = K / BK;
    unsigned voffA[2], voffB[2];
#pragma unroll
    for (int i = 0; i < 2; ++i) { int R, C; stage_rc(tid * 16 + i * 8192, R, C); const int Rb = Epi::PERM ? ((R & ~31) + perm32(R & 31)) : R;
        voffA[i] = (unsigned)(R * K + C) * 2u; voffB[i] = (unsigned)(Rb * K + C) * 2u; }
    const size_t kstep = (size_t)(BK * 2);
    const size_t hstep = (size_t)HALF * K * 2;
    const size_t tstep = 2 * hstep;
    const unsigned ldsw = (unsigned)wid * 1024u;
    const int aoff = lds_byte(wr * 64 + fr, fq * 8), boff = lds_byte(wc * 32 + fr, fq * 8);
#define PG8_SA(b, h) (((b) * 2 + (h)) * HTB)
#define PG8_SB(b, h) ((4 + (b) * 2 + (h)) * HTB)
#define PG8_STAGE(bufoff, gbase, voff) do { _Pragma("unroll") for (int _i = 0; _i < 2; ++_i) \
        __builtin_amdgcn_global_load_lds((const unsigned*)((const char*)(gbase) + (voff)[_i]), (PG8_LAS unsigned*)(lds + (bufoff) + ldsw + _i * 8192), 16, 0, 0); } while (0)
#define PG8_LDA(dst, b, h) do { _Pragma("unroll") for (int m = 0; m < 4; ++m) _Pragma("unroll") for (int k = 0; k < 2; ++k) dst[m][k] = *(const PG8_LAS bf16x8*)(lds + PG8_SA(b, h) + aoff + m * 2048 + k * 1024); } while (0)
#define PG8_LDB(dst, b, h) do { _Pragma("unroll") for (int n = 0; n < 2; ++n) _Pragma("unroll") for (int k = 0; k < 2; ++k) dst[n][k] = *(const PG8_LAS bf16x8*)(lds + PG8_SB(b, h) + boff + n * 2048 + k * 1024); } while (0)
#define PG8_MMA(ai, bj, At, Bt) do { __builtin_amdgcn_s_setprio(1); _Pragma("unroll") for (int m = 0; m < 4; ++m) _Pragma("unroll") for (int n = 0; n < 2; ++n) _Pragma("unroll") for (int k = 0; k < 2; ++k) \
        acc[ai][bj][m][n] = __builtin_amdgcn_mfma_f32_16x16x32_bf16(Bt[n][k], At[m][k], acc[ai][bj][m][n], 0, 0, 0); __builtin_amdgcn_s_setprio(0); } while (0)
#define PG8_WAIT_V(n) asm volatile("s_waitcnt vmcnt(" #n ")" ::: "memory")
#define PG8_WAIT_L(n) asm volatile("s_waitcnt lgkmcnt(" #n ")" ::: "memory")
#define PG8_BAR __builtin_amdgcn_s_barrier()
#define PG8_SCHED __builtin_amdgcn_sched_barrier(0)
    Unit cur, nxt; int ui = 0;
    if (!S.next(0, cur)) return;
    f32x4 acc[2][2][4][2];
#pragma unroll
    for (int a = 0; a < 2; ++a)
#pragma unroll
        for (int b = 0; b < 2; ++b)
#pragma unroll
            for (int m = 0; m < 4; ++m)
#pragma unroll
                for (int n = 0; n < 2; ++n) acc[a][b][m][n] = (f32x4){0.f, 0.f, 0.f, 0.f};
    bf16x8 At[4][2], B0[2][2], B1[2][2];
    const char* cA = (const char*)g.A + (size_t)cur.pm * tstep; const char* cB = (const char*)g.Bt + (size_t)cur.pn * tstep;
    S.a_ready(cur);
    if constexpr (SP2) {
        PG8_STAGE(PG8_SB(0, 0), cB, voffB); PG8_STAGE(PG8_SB(0, 1), cB + hstep, voffB); PG8_STAGE(PG8_SA(0, 0), cA, voffA); PG8_STAGE(PG8_SA(0, 1), cA + hstep, voffA);
        if (wr == 1) PG8_BAR;
        PG8_WAIT_V(2); PG8_BAR;
        PG8_STAGE(PG8_SB(1, 0), cB + kstep, voffB); PG8_STAGE(PG8_SA(1, 0), cA + kstep, voffA); PG8_STAGE(PG8_SB(1, 1), cB + hstep + kstep, voffB);
        PG8_WAIT_V(6); PG8_BAR;
    } else {
        PG8_STAGE(PG8_SB(0, 0), cB, voffB); PG8_STAGE(PG8_SA(0, 0), cA, voffA); PG8_STAGE(PG8_SB(0, 1), cB + hstep, voffB); PG8_STAGE(PG8_SA(0, 1), cA + hstep, voffA);
        if (wr == 1) PG8_BAR;
        PG8_WAIT_V(4); PG8_BAR;
        PG8_STAGE(PG8_SB(1, 0), cB + kstep, voffB); PG8_STAGE(PG8_SA(1, 0), cA + kstep, voffA); PG8_STAGE(PG8_SB(1, 1), cB + hstep + kstep, voffB);
        PG8_WAIT_V(6); PG8_BAR;
    }
    for (;;) {
        const bool has_next = S.next(ui + 1, nxt);
        const char* nA = has_next ? (const char*)g.A + (size_t)nxt.pm * tstep : cA; const char* nB = has_next ? (const char*)g.Bt + (size_t)nxt.pn * tstep : cB;
        for (int t = 0; t < nt; t += 2) {
            const bool last = (t == nt - 2);
            const char* a1 = cA + (size_t)(t + 1) * kstep;
            const char* a2 = last ? nA : cA + (size_t)(t + 2) * kstep; const char* b2 = last ? nB : cB + (size_t)(t + 2) * kstep;
            const char* a3 = a2 + kstep; const char* b3 = b2 + kstep;
            if (last && has_next) S.a_ready(nxt);
            if constexpr (SP2) {
            PG8_LDB(B0, 0, 0); PG8_LDB(B1, 0, 1); PG8_SCHED; PG8_LDA(At, 0, 0); PG8_STAGE(PG8_SA(1, 1), a1 + hstep, voffA);
            PG8_WAIT_V(8); PG8_WAIT_L(0); PG8_BAR; PG8_MMA(0, 0, At, B0); PG8_MMA(0, 1, At, B1); PG8_BAR; PG8_SCHED;
            PG8_LDA(At, 0, 1); PG8_STAGE(PG8_SB(0, 0), b2, voffB); PG8_STAGE(PG8_SB(0, 1), b2 + hstep, voffB); PG8_STAGE(PG8_SA(0, 0), a2, voffA);
            PG8_WAIT_V(8); PG8_WAIT_L(0); PG8_BAR; PG8_MMA(1, 0, At, B0); PG8_MMA(1, 1, At, B1); PG8_BAR; PG8_SCHED;
            PG8_LDB(B0, 1, 0); PG8_LDB(B1, 1, 1); PG8_SCHED; PG8_LDA(At, 1, 0); PG8_STAGE(PG8_SA(0, 1), a2 + hstep, voffA);
            PG8_WAIT_V(8); PG8_WAIT_L(0); PG8_BAR; PG8_MMA(0, 0, At, B0); PG8_MMA(0, 1, At, B1); PG8_BAR; PG8_SCHED;
            PG8_LDA(At, 1, 1); PG8_STAGE(PG8_SB(1, 0), b3, voffB); PG8_STAGE(PG8_SB(1, 1), b3 + hstep, voffB); PG8_STAGE(PG8_SA(1, 0), a3, voffA);
            PG8_WAIT_V(8); PG8_WAIT_L(0); PG8_BAR; PG8_MMA(1, 0, At, B0); PG8_MMA(1, 1, At, B1); PG8_BAR; PG8_SCHED;
            } else {
            PG8_LDB(B0, 0, 0); PG8_SCHED; PG8_LDA(At, 0, 0); PG8_STAGE(PG8_SA(1, 1), a1 + hstep, voffA);
            PG8_WAIT_L(8); PG8_BAR; PG8_WAIT_L(0); PG8_MMA(0, 0, At, B0); PG8_BAR; PG8_SCHED;
            PG8_LDB(B1, 0, 1); PG8_STAGE(PG8_SB(0, 0), b2, voffB);
            PG8_BAR; PG8_WAIT_L(0); PG8_MMA(0, 1, At, B1); PG8_BAR;
            PG8_LDA(At, 0, 1); PG8_STAGE(PG8_SA(0, 0), a2, voffA);
            PG8_BAR; PG8_WAIT_L(0); PG8_MMA(1, 0, At, B0); PG8_BAR; PG8_SCHED;
            PG8_STAGE(PG8_SB(0, 1), b2 + hstep, voffB);
            PG8_WAIT_V(6); PG8_BAR; PG8_MMA(1, 1, At, B1); PG8_BAR;
            PG8_LDB(B0, 1, 0); PG8_SCHED; PG8_LDA(At, 1, 0); PG8_STAGE(PG8_SA(0, 1), a2 + hstep, voffA);
            PG8_WAIT_L(8); PG8_BAR; PG8_WAIT_L(0); PG8_MMA(0, 0, At, B0); PG8_BAR; PG8_SCHED;
            PG8_LDB(B1, 1, 1); PG8_STAGE(PG8_SB(1, 0), b3, voffB);
            PG8_BAR; PG8_WAIT_L(0); PG8_MMA(0, 1, At, B1); PG8_BAR;
            PG8_LDA(At, 1, 1); PG8_STAGE(PG8_SA(1, 0), a3, voffA);
            PG8_BAR; PG8_WAIT_L(0); PG8_MMA(1, 0, At, B0); PG8_BAR; PG8_SCHED;
            PG8_STAGE(PG8_SB(1, 1), b3 + hstep, voffB);
            PG8_WAIT_V(6); PG8_BAR; PG8_MMA(1, 1, At, B1); PG8_BAR;
            }
        }
        if constexpr (ALIGN_EPI) { if (wr == 0) PG8_BAR; }
        if constexpr (!Epi::AFTER_DRAIN) { E(acc, cur, wr, wc, fr, fq); S.done(cur); }
        if (!has_next) break;
#pragma unroll
        for (int a = 0; a < 2; ++a)
#pragma unroll
            for (int b = 0; b < 2; ++b)
#pragma unroll
                for (int m = 0; m < 4; ++m)
#pragma unroll
                    for (int n = 0; n < 2; ++n) acc[a][b][m][n] = (f32x4){0.f, 0.f, 0.f, 0.f};
        cur = nxt; cA = nA; cB = nB; ++ui;
        if constexpr (ALIGN_EPI) { if (wr == 1) PG8_BAR; }
    }
    PG8_WAIT_V(0);
    if constexpr (!ALIGN_EPI) { if (wr == 0) PG8_BAR; }
    PG8_BAR;
    if constexpr (Epi::AFTER_DRAIN) { E.fused(acc, cur, wr, wc, fr, fq, lds, wid, lane); S.done(cur); }
#undef PG8_SA
#undef PG8_SB
#undef PG8_STAGE
#undef PG8_LDA
#undef PG8_LDB
#undef PG8_MMA
#undef PG8_WAIT_V
#undef PG8_WAIT_L
#undef PG8_BAR
#undef PG8_SCHED
}
}
#define LAS __attribute__((address_space(3)))
typedef unsigned short bf16_t;
typedef unsigned v4u __attribute__((ext_vector_type(4)));
typedef unsigned v2u __attribute__((ext_vector_type(2)));
typedef float f32x4 __attribute__((ext_vector_type(4)));
typedef float f32x2 __attribute__((ext_vector_type(2)));
typedef short bf16x8 __attribute__((ext_vector_type(8)));
constexpr int MTOK = 8192, DM = 2048, NIN = 18432, DMIX = 4096, PLED = 256, SEQL = 2048;
constexpr size_t MiB = (size_t)1 << 20;
constexpr size_t SECN = (size_t)MTOK * 2048;
constexpr size_t WS_WIN = 0, WS_HN = 72 * MiB, WS_WOUT = 104 * MiB, WS_WG = 120 * MiB, WS_WP = 128 * MiB, WS_PB = 129 * MiB;
constexpr size_t WS_PROJ = 136 * MiB, WS_OF = 424 * MiB, WS_PART = 552 * MiB, WS_CTL = 553 * MiB, WS_LBO = WS_CTL + 65536, WS_END = 554 * MiB;
constexpr size_t WS_CAT = WS_PROJ, WS_H = WS_PROJ + 64 * MiB, WS_HB = WS_WIN;
constexpr int MISC_OFF = 156672, LDS_BYTES = MISC_OFF + 64;
constexpr float EPSV = 1e-6f;
#define LDS_WAIT() asm volatile("s_waitcnt lgkmcnt(0)" ::: "memory")

__device__ __forceinline__ unsigned pk2(float lo, float hi) { unsigned r; asm volatile("v_cvt_pk_bf16_f32 %0, %1, %2" : "=v"(r) : "v"(lo), "v"(hi)); return r; }
typedef __bf16 bf16x2_t __attribute__((ext_vector_type(2)));
__device__ __forceinline__ unsigned pk2m(float lo, float hi) { f32x2 v; v.x = lo; v.y = hi; const bf16x2_t r = __builtin_convertvector(v, bf16x2_t); return __builtin_bit_cast(unsigned, r); }
__device__ __forceinline__ float bf_lo(unsigned u) { return __uint_as_float(u << 16); }
__device__ __forceinline__ float bf_hi(unsigned u) { return __uint_as_float(u & 0xffff0000u); }
__device__ __forceinline__ float wave_sum(float v) {
#pragma unroll
    for (int o = 1; o < 64; o <<= 1) v += __shfl_xor(v, o);
    return v;
}
__device__ __forceinline__ float sigm(float v) { return __builtin_amdgcn_rcpf(1.0f + __builtin_amdgcn_exp2f(-1.44269504f * v)); }

struct Args { const float* in[12]; float* out; unsigned char* ws; int ph_lo, ph_hi; };

template <bool REMAP> __device__ __forceinline__ void transpose_item(const float* W, int K, int N, bf16_t* WT, LAS float* scr, int item, int lane) {
    const int nblk = N / 32, kb = item / nblk, nb = item % nblk, k0 = 64 * kb, n0 = 32 * nb;
    int d0 = n0;
    if (REMAP && n0 >= 12288 && n0 < 16384) { const int sec7 = n0 >= 14336, cc = n0 - (sec7 ? 14336 : 12288); d0 = 12288 + (cc >> 7) * 256 + sec7 * 128 + (cc & 127); }
#pragma unroll 8
    for (int i = 0; i < 32; ++i) { const int kk = 2 * i + (lane >> 5); scr[kk * 33 + (lane & 31)] = __builtin_nontemporal_load(&W[(size_t)(k0 + kk) * N + n0 + (lane & 31)]); }
    LDS_WAIT();
    const int c = lane & 7;
#pragma unroll
    for (int j = 0; j < 4; ++j) { const int n = (lane >> 3) + 8 * j; const LAS float* s = scr + (8 * c) * 33 + n;
        v4u o; o.x = pk2(s[0 * 33], s[1 * 33]); o.y = pk2(s[2 * 33], s[3 * 33]); o.z = pk2(s[4 * 33], s[5 * 33]); o.w = pk2(s[6 * 33], s[7 * 33]);
        *(v4u*)(WT + (size_t)(d0 + n) * K + k0 + 8 * c) = o; }
    LDS_WAIT();
}
__device__ __forceinline__ void prep_phase(LAS unsigned char* lds, const Args& a, int bid, int nblk) {
    const int lane = threadIdx.x & 63, w = threadIdx.x >> 6;
    LAS float* scr = (LAS float*)(lds + w * 8704);
    const int gw = bid * 8 + w, NGW = nblk * 8;
    unsigned char* ws = a.ws;
    constexpr int I_IN = (DM / 64) * (NIN / 32), I_OUT = (DMIX / 64) * (DM / 32), I_G = (DM / 64) * (DM / 32), I_P = (PLED / 64) * (DM / 32);
    for (int it = gw; it < I_IN + I_OUT + I_G + I_P; it += NGW) {
        int r = it;
        if (r < I_IN) { transpose_item<true>(a.in[3], DM, NIN, (bf16_t*)(ws + WS_WIN), scr, r, lane); continue; } r -= I_IN;
        if (r < I_OUT) { transpose_item<false>(a.in[8], DMIX, DM, (bf16_t*)(ws + WS_WOUT), scr, r, lane); continue; } r -= I_OUT;
        if (r < I_G) { transpose_item<false>(a.in[10], DM, DM, (bf16_t*)(ws + WS_WG), scr, r, lane); continue; } r -= I_G;
        transpose_item<false>(a.in[9], PLED, DM, (bf16_t*)(ws + WS_WP), scr, r, lane);
    }
    const float* x = a.in[0]; const float* nw = a.in[2]; bf16_t* hn = (bf16_t*)(ws + WS_HN);
    for (int row = gw; row < MTOK; row += NGW) {
        const f32x4* xr = (const f32x4*)(x + (size_t)row * DM) + lane;
        f32x4 v[8]; float s = 0.f;
#pragma unroll
        for (int j = 0; j < 8; ++j) { v[j] = __builtin_nontemporal_load(&xr[64 * j]); s += (v[j].x * v[j].x + v[j].y * v[j].y) + (v[j].z * v[j].z + v[j].w * v[j].w); }
        const float rstd = __builtin_amdgcn_rsqf(wave_sum(s) * (1.f / DM) + EPSV);
        v2u* o = (v2u*)(hn + (size_t)row * DM) + lane;
#pragma unroll
        for (int j = 0; j < 8; ++j) { const f32x4 g = *((const f32x4*)nw + lane + 64 * j);
            v2u q; q.x = pk2(v[j].x * rstd * g.x, v[j].y * rstd * g.y); q.y = pk2(v[j].z * rstd * g.z, v[j].w * rstd * g.w); o[64 * j] = q; }
    }
    const f32x4* p4 = (const f32x4*)a.in[1]; v2u* pb = (v2u*)(ws + WS_PB);
    for (int i = gw * 64 + lane; i < MTOK * PLED / 4; i += NGW * 64) { const f32x4 v = __builtin_nontemporal_load(&p4[i]); v2u q; q.x = pk2(v.x, v.y); q.y = pk2(v.z, v.w); pb[i] = q; }
}

constexpr int SQ = 136, SK = 72;
constexpr int B_QR = 0, B_KR = 17408, B_KRT = 34816, B_VT = 53248, BUF_SZ = 62464;
constexpr int P2_P = 2 * BUF_SZ, P2_ST = P2_P + 9216, P2_SEG = P2_ST + 17408, P2_CH = P2_SEG + 2048;
static_assert(P2_CH + 2 * 1536 <= MISC_OFF, "P2 LDS map");
#define MFMA16(a, b, c) __builtin_amdgcn_mfma_f32_16x16x32_bf16(a, b, c, 0, 0, 0)
#define LBAR() do { asm volatile("s_waitcnt lgkmcnt(0)" ::: "memory"); __builtin_amdgcn_s_barrier(); asm volatile("" ::: "memory"); } while (0)
__device__ __forceinline__ bf16x8 frag(LAS unsigned char* lds, int base, int r0, int ks, int rs, int fr, int fq) { return *(const LAS bf16x8*)(lds + base + ((r0 + fr) * rs + ks * 32 + 8 * fq) * 2); }

template <int DIR> __device__ __forceinline__ void hgrn_item(LAS unsigned char* lds, const Args& a, const bf16_t* proj, int item) {
    const int tid = threadIdx.x, lane = tid & 63, w = __builtin_amdgcn_readfirstlane(tid >> 6), fr = lane & 15, fq = lane >> 4;
    const bool prod = w < 4;
    const int pw = w & 3, cw = w & 3, cp = lane, ptid = pw * 64 + lane, vcp = ptid & 31, sseg = ptid >> 5;
    constexpr int dir = DIR;
    const int vh = item & 1, h = (item >> 2) & 15, b = item >> 6;
    const size_t hb = (size_t)(b * 16 + h) * 2048 * 128;
    const bf16_t* qb = proj + hb; const bf16_t* fb = proj + (size_t)(2 + dir) * SECN + hb; const bf16_t* vb = proj + SECN + hb + vh * 64;
    const unsigned qlo = 2 * cp, vlo = (dir ? 8 * (1 - (lane >> 5)) : 8 * (lane >> 5)) * 128 + 2 * vcp;
    bf16_t* ob = (bf16_t*)(a.ws + WS_OF) + (size_t)item * (2048 * 64);
    const int tokbase = 0;
    for (int i = tid; i < 2304; i += 512) ((LAS unsigned*)(lds + P2_P))[i] = 0u;
    f32x4 S[2][4];
#pragma unroll
    for (int ct = 0; ct < 2; ++ct)
#pragma unroll
        for (int nt = 0; nt < 4; ++nt) S[ct][nt] = (f32x4){0.f, 0.f, 0.f, 0.f};
    unsigned qreg[16], freg[16], vreg[8];
#define P2_LOADK(n, F) do { const int c0 = 64 * (DIR ? 31 - (n) : (n)); \
        const bf16_t* fp_ = fb + (size_t)(DIR ? c0 + 63 - 16 * pw : c0 + 16 * pw) * 128 + qlo; \
        _Pragma("unroll") for (int i = 0; i < 16; ++i) F[i] = *(const unsigned*)(fp_ + (DIR ? -i : i) * 128); } while (0)
#define P2_LOADV(n) do { const int c0 = 64 * (DIR ? 31 - (n) : (n)); \
        const bf16_t* vp_ = vb + (size_t)(DIR ? c0 + 55 - 16 * pw : c0 + 16 * pw) * 128 + vlo; \
        _Pragma("unroll") for (int i = 0; i < 8; ++i) vreg[i] = *(const unsigned*)(vp_ + (DIR ? -i : i) * 128); } while (0)
#define P2_LOADQ(n, Q) do { const int c0 = 64 * (DIR ? 31 - (n) : (n)); \
        const bf16_t* qp_ = qb + (size_t)(DIR ? c0 + 63 - 16 * pw : c0 + 16 * pw) * 128 + qlo; \
        _Pragma("unroll") for (int i = 0; i < 16; ++i) Q[i] = *(const unsigned*)(qp_ + (DIR ? -i : i) * 128); } while (0)
    unsigned knx[16];
    unsigned qnx[16];
    if (prod) { P2_LOADK(0, freg); P2_LOADV(0); P2_LOADQ(0, qreg); }
    for (int step = -1; step < 32; ++step) {
        const int n1 = step + 1;
        if (prod) {
            if (n1 < 32) {
                if (n1 + 1 < 32) { P2_LOADK(n1 + 1, knx); P2_LOADQ(n1 + 1, qnx); }
                f32x2 run = (f32x2){1.f, 1.f};
#pragma unroll
                for (int i = 0; i < 16; ++i) { const f32x2 kv = (f32x2){bf_lo(freg[i]), bf_hi(freg[i])}; run = run * ((f32x2){1.f, 1.f} - kv); }
                *(LAS f32x2*)(lds + P2_SEG + (pw * 128 + 2 * cp) * 4) = run;
                { const int base = (n1 & 1) * BUF_SZ;
#pragma unroll
                for (int e = 0; e < 2; ++e) { v4u t;
                    if (e == 0) { t.x = (vreg[0] & 0xffffu) | (vreg[1] << 16); t.y = (vreg[2] & 0xffffu) | (vreg[3] << 16); t.z = (vreg[4] & 0xffffu) | (vreg[5] << 16); t.w = (vreg[6] & 0xffffu) | (vreg[7] << 16); }
                    else { t.x = (vreg[0] >> 16) | (vreg[1] & 0xffff0000u); t.y = (vreg[2] >> 16) | (vreg[3] & 0xffff0000u); t.z = (vreg[4] >> 16) | (vreg[5] & 0xffff0000u); t.w = (vreg[6] >> 16) | (vreg[7] & 0xffff0000u); }
                    *(LAS v4u*)(lds + base + B_VT + ((2 * vcp + e) * SK + 8 * sseg) * 2) = t; }
                }
                if (n1 + 1 < 32) P2_LOADV(n1 + 1);
            }
        } else if (step >= 0) {
            const int base = (step & 1) * BUF_SZ, ch = P2_CH + (step & 1) * 1536;
#pragma unroll
            for (int ct = 0; ct < 2; ++ct) { const f32x4 em = *(const LAS f32x4*)(lds + ch + (32 * cw + 16 * ct + 4 * fq) * 4);
#pragma unroll
                for (int nt = 0; nt < 4; ++nt) { const f32x4 v = S[ct][nt] * em; v2u z; z.x = pk2m(v[0], v[1]); z.y = pk2m(v[2], v[3]);
                    *(LAS v2u*)(lds + P2_ST + ((16 * nt + fr) * SQ + 32 * cw + 16 * ct + 4 * fq) * 2) = z; } }
            {   const int ti0 = cw < 2 ? 3 : 2, sj0 = (cw & 1) * 2;
                const int ti1 = cw == 3 ? 1 : ti0, sj1 = cw == 3 ? 1 : sj0 + 1;
                const int ti2 = cw == 0 ? 0 : 1; const bool v2 = !(cw & 1);
                f32x4 a0 = (f32x4){0.f, 0.f, 0.f, 0.f}, a1 = a0, a2 = a0;
#pragma unroll
                for (int ks = 0; ks < 4; ++ks) {
                    a0 = MFMA16(frag(lds, base + B_KR, 16 * sj0, ks, SQ, fr, fq), frag(lds, base + B_QR, 16 * ti0, ks, SQ, fr, fq), a0);
                    a1 = MFMA16(frag(lds, base + B_KR, 16 * sj1, ks, SQ, fr, fq), frag(lds, base + B_QR, 16 * ti1, ks, SQ, fr, fq), a1);
                    if (v2) a2 = MFMA16(frag(lds, base + B_KR, 0, ks, SQ, fr, fq), frag(lds, base + B_QR, 16 * ti2, ks, SQ, fr, fq), a2);
                }
#pragma unroll
                for (int j = 0; j < 4; ++j) { const bool keep = (4 * fq + j <= fr); if (ti0 == sj0) a0[j] = keep ? a0[j] : 0.f; if (ti1 == sj1) a1[j] = keep ? a1[j] : 0.f; if (ti2 == 0) a2[j] = keep ? a2[j] : 0.f; }
                { v2u z; z.x = pk2m(a0[0], a0[1]); z.y = pk2m(a0[2], a0[3]); *(LAS v2u*)(lds + P2_P + ((16 * ti0 + fr) * SK + 16 * sj0 + 4 * fq) * 2) = z; }
                { v2u z; z.x = pk2m(a1[0], a1[1]); z.y = pk2m(a1[2], a1[3]); *(LAS v2u*)(lds + P2_P + ((16 * ti1 + fr) * SK + 16 * sj1 + 4 * fq) * 2) = z; }
                if (v2) { v2u z; z.x = pk2m(a2[0], a2[1]); z.y = pk2m(a2[2], a2[3]); *(LAS v2u*)(lds + P2_P + ((16 * ti2 + fr) * SK + 4 * fq) * 2) = z; }
            }
#pragma unroll
            for (int ct = 0; ct < 2; ++ct) {
                const f32x4 el = *(const LAS f32x4*)(lds + ch + 512 + (32 * cw + 16 * ct + 4 * fq) * 4);
#pragma unroll
                for (int nt = 0; nt < 4; ++nt) S[ct][nt] = el * S[ct][nt];
#pragma unroll
                for (int ks = 0; ks < 2; ++ks) { const bf16x8 ak = frag(lds, base + B_KRT, 32 * cw + 16 * ct, ks, SK, fr, fq);
#pragma unroll
                    for (int nt = 0; nt < 4; ++nt) S[ct][nt] = MFMA16(ak, frag(lds, base + B_VT, 16 * nt, ks, SK, fr, fq), S[ct][nt]); }
            }
        }
        LBAR();
        if (prod) {
            if (n1 < 32) {
                const int base = (n1 & 1) * BUF_SZ, ch = P2_CH + (n1 & 1) * 1536;
                f32x2 off = (f32x2){1.f, 1.f}, emid, elast;
                {   const f32x2 g0 = *(const LAS f32x2*)(lds + P2_SEG + (0 * 128 + 2 * cp) * 4), g1 = *(const LAS f32x2*)(lds + P2_SEG + (1 * 128 + 2 * cp) * 4);
                    const f32x2 g2 = *(const LAS f32x2*)(lds + P2_SEG + (2 * 128 + 2 * cp) * 4), g3 = *(const LAS f32x2*)(lds + P2_SEG + (3 * 128 + 2 * cp) * 4);
                    emid = g0 * g1; elast = emid * g2 * g3; off = pw == 0 ? off : (pw == 1 ? g0 : (pw == 2 ? emid : emid * g2)); }
                f32x2 rmid; rmid.x = __builtin_amdgcn_rcpf(emid.x); rmid.y = __builtin_amdgcn_rcpf(emid.y);
                const f32x2 gk = elast * rmid;
#pragma unroll
                for (int hf = 0; hf < 2; ++hf) {
                    f32x2 bl[8];
#pragma unroll
                    for (int i8 = 0; i8 < 8; ++i8) { const int i = 8 * hf + i8;
                        const f32x2 kv = (f32x2){bf_lo(freg[i]), bf_hi(freg[i])}, q2 = (f32x2){bf_lo(qreg[i]), bf_hi(qreg[i])};
                        off = off * ((f32x2){1.f, 1.f} - kv);
                        f32x2 rE; rE.x = __builtin_amdgcn_rcpf(off.x); rE.y = __builtin_amdgcn_rcpf(off.y);
                        const f32x2 qr = q2 * (off * rmid); bl[i8] = kv * (emid * rE);
                        const int po = ((16 * pw + i) * SQ + 2 * cp) * 2;
                        *(LAS unsigned*)(lds + base + B_QR + po) = pk2(qr.x, qr.y); *(LAS unsigned*)(lds + base + B_KR + po) = pk2(bl[i8].x, bl[i8].y);
                    }
#pragma unroll
                    for (int i8 = 0; i8 < 8; ++i8) bl[i8] = bl[i8] * gk;
                    { v4u t; t.x = pk2(bl[0].x, bl[1].x); t.y = pk2(bl[2].x, bl[3].x); t.z = pk2(bl[4].x, bl[5].x); t.w = pk2(bl[6].x, bl[7].x);
                      *(LAS v4u*)(lds + base + B_KRT + ((2 * cp) * SK + 16 * pw + 8 * hf) * 2) = t;
                      t.x = pk2(bl[0].y, bl[1].y); t.y = pk2(bl[2].y, bl[3].y); t.z = pk2(bl[4].y, bl[5].y); t.w = pk2(bl[6].y, bl[7].y);
                      *(LAS v4u*)(lds + base + B_KRT + ((2 * cp + 1) * SK + 16 * pw + 8 * hf) * 2) = t; }
                }
                if (n1 + 1 < 32) {
#pragma unroll
                    for (int i = 0; i < 16; ++i) { qreg[i] = qnx[i]; freg[i] = knx[i]; } }
                if (pw == 0) { *(LAS f32x2*)(lds + ch + (2 * cp) * 4) = emid; *(LAS f32x2*)(lds + ch + 512 + (2 * cp) * 4) = elast; *(LAS f32x2*)(lds + ch + 1024 + (2 * cp) * 4) = elast * rmid; }
            }
        } else if (step >= 0) {
            const int base = (step & 1) * BUF_SZ, t0 = 16 * cw;
            f32x4 ao[4];
#pragma unroll
            for (int nt = 0; nt < 4; ++nt) ao[nt] = (f32x4){0.f, 0.f, 0.f, 0.f};
#pragma unroll
            for (int ks = 0; ks < 4; ++ks) { const bf16x8 bq = frag(lds, base + B_QR, t0, ks, SQ, fr, fq);
#pragma unroll
                for (int nt = 0; nt < 4; ++nt) ao[nt] = MFMA16(frag(lds, P2_ST, 16 * nt, ks, SQ, fr, fq), bq, ao[nt]); }
#pragma unroll
            for (int ks = 0; ks < 2; ++ks) if (ks == 0 || cw >= 2) { const bf16x8 bp = frag(lds, P2_P, t0, ks, SK, fr, fq);
#pragma unroll
                for (int nt = 0; nt < 4; ++nt) ao[nt] = MFMA16(frag(lds, base + B_VT, 16 * nt, ks, SK, fr, fq), bp, ao[nt]); }
            const int j = t0 + fr; const int tok = dir ? (tokbase + 64 * (31 - step) + 63 - j) : (tokbase + 64 * step + j);
#pragma unroll
            for (int nt = 0; nt < 4; ++nt) { v2u z; z.x = pk2m(ao[nt][0], ao[nt][1]); z.y = pk2m(ao[nt][2], ao[nt][3]); *(v2u*)(ob + (unsigned)(tok * 64 + 16 * nt + 4 * fq)) = z; }
        }
        LBAR();
    }
}

__device__ __forceinline__ void hgrn_phase(LAS unsigned char* lds, const Args& a, int bid, int nblk) {
    const bf16_t* proj = (const bf16_t*)(a.ws + WS_PROJ);
    for (int it = bid; it < 256; it += nblk) {
        const int item = (nblk == 256) ? (((it & 7) * 8 + (it >> 5)) * 4 + ((it >> 3) & 3)) : it;
        if ((item >> 1) & 1) hgrn_item<1>(lds, a, proj, item); else hgrn_item<0>(lds, a, proj, item);
    }
}

__device__ __forceinline__ void unpack8(const v4u u, float (&f)[8]) { f[0] = bf_lo(u.x); f[1] = bf_hi(u.x); f[2] = bf_lo(u.y); f[3] = bf_hi(u.y); f[4] = bf_lo(u.z); f[5] = bf_hi(u.z); f[6] = bf_lo(u.w); f[7] = bf_hi(u.w); }
__device__ __forceinline__ void conv_y(const bf16_t* proj, const LAS float* cw, int row, int e0, bool hasp, bool hasn, float (&y)[8]) {
    const size_t off = (size_t)row * 2048 + e0;
    float bg[8], u0[8], um[8], un[8];
    unpack8(__builtin_nontemporal_load((const v4u*)(proj + 5 * SECN + off)), bg); unpack8(*(const v4u*)(proj + 6 * SECN + off), u0);
    v4u zz; zz.x = 0u; zz.y = 0u; zz.z = 0u; zz.w = 0u;
    unpack8(hasp ? *(const v4u*)(proj + 6 * SECN + off - 2048) : zz, um); unpack8(hasn ? *(const v4u*)(proj + 6 * SECN + off + 2048) : zz, un);
    const f32x4 w00 = *(const LAS f32x4*)(cw + e0), w01 = *(const LAS f32x4*)(cw + e0 + 4), w10 = *(const LAS f32x4*)(cw + 2048 + e0), w11 = *(const LAS f32x4*)(cw + 2048 + e0 + 4), w20 = *(const LAS f32x4*)(cw + 4096 + e0), w21 = *(const LAS f32x4*)(cw + 4096 + e0 + 4);
#pragma unroll
    for (int j = 0; j < 8; ++j) { const float wa = j < 4 ? w00[j] : w01[j - 4], wb = j < 4 ? w10[j] : w11[j - 4], wc = j < 4 ? w20[j] : w21[j - 4];
        y[j] = bg[j] * (wa * um[j] + wb * u0[j] + wc * un[j]); }
}
__device__ __forceinline__ void mix_phase(LAS unsigned char* lds, const Args& a, int bid, int nblk) {
    const int lane = threadIdx.x & 63, w = threadIdx.x >> 6;
    const int gw = bid * 8 + w, NGW = nblk * 8;
    const bf16_t* proj = (const bf16_t*)(a.ws + WS_PROJ);
    const bf16_t* OF = (const bf16_t*)(a.ws + WS_OF);
    LAS float* hw = (LAS float*)lds; LAS float* cnw = hw + 2048; LAS float* cw = hw + 4096;
    {   const f32x4* s0 = (const f32x4*)a.in[5]; const f32x4* s1 = (const f32x4*)a.in[7]; const f32x4* s2 = (const f32x4*)a.in[6];
        LAS f32x4* d = (LAS f32x4*)lds;
        for (int i = threadIdx.x; i < 512; i += 512) { d[i] = s0[i]; d[512 + i] = s1[i]; }
        for (int i = threadIdx.x; i < 1536; i += 512) d[1024 + i] = s2[i];
        __syncthreads(); }
    bf16_t* cat = (bf16_t*)(a.ws + WS_CAT);
    for (int row = gw; row < MTOK; row += NGW) {
        const int t = row & (SEQL - 1);
        const bool hasp = t > 0, hasn = t < SEQL - 1;
#pragma unroll 1
        for (int ps = 0; ps < 4; ++ps) {
            const int e0 = ps * 512 + lane * 8; const size_t off = (size_t)row * 2048 + e0;
            const size_t io = ((size_t)(((row >> 11) * 64 + (e0 >> 7) * 4 + ((e0 >> 6) & 1)) * 2048 + t) * 64) + (e0 & 63);
            float o[8], ob8[8]; float ss = 0.f; unpack8(__builtin_nontemporal_load((const v4u*)(OF + io)), o); unpack8(__builtin_nontemporal_load((const v4u*)(OF + io + (size_t)2 * 2048 * 64)), ob8);
#pragma unroll
            for (int j = 0; j < 8; ++j) o[j] += ob8[j];
#pragma unroll
            for (int j = 0; j < 8; ++j) ss += o[j] * o[j];
            ss += __shfl_xor(ss, 1); ss += __shfl_xor(ss, 2); ss += __shfl_xor(ss, 4); ss += __shfl_xor(ss, 8);
            const float rstd = __builtin_amdgcn_rsqf(ss * (1.f / 128.f) + EPSV);
            float z[8]; unpack8(__builtin_nontemporal_load((const v4u*)(proj + 4 * SECN + off)), z);
            const f32x4 g0 = *(const LAS f32x4*)(hw + e0), g1 = *(const LAS f32x4*)(hw + e0 + 4);
            float r[8];
#pragma unroll
            for (int j = 0; j < 8; ++j) r[j] = o[j] * rstd * (j < 4 ? g0[j] : g1[j - 4]) * z[j] * sigm(z[j]);
            v4u q; q.x = pk2(r[0], r[1]); q.y = pk2(r[2], r[3]); q.z = pk2(r[4], r[5]); q.w = pk2(r[6], r[7]);
            *(v4u*)(cat + (size_t)row * 4096 + e0) = q;
        }
        float ss = 0.f; unsigned yp[4][4];
#pragma unroll
        for (int ps = 0; ps < 4; ++ps) { float y[8]; __builtin_amdgcn_sched_barrier(0); conv_y(proj, cw, row, ps * 512 + lane * 8, hasp, hasn, y);
#pragma unroll
            for (int j = 0; j < 8; ++j) ss += y[j] * y[j];
#pragma unroll
            for (int j = 0; j < 4; ++j) yp[ps][j] = pk2(y[2 * j], y[2 * j + 1]); }
        const float rstd = __builtin_amdgcn_rsqf(wave_sum(ss) * (1.f / 2048.f) + EPSV);
#pragma unroll
        for (int ps = 0; ps < 4; ++ps) {
            const int e0 = ps * 512 + lane * 8; const size_t off = (size_t)row * 2048 + e0;
            float y[8]; { v4u t; t.x = yp[ps][0]; t.y = yp[ps][1]; t.z = yp[ps][2]; t.w = yp[ps][3]; unpack8(t, y); }
            float z[8]; unpack8(__builtin_nontemporal_load((const v4u*)(proj + 8 * SECN + off)), z);
            const f32x4 g0 = *(const LAS f32x4*)(cnw + e0), g1 = *(const LAS f32x4*)(cnw + e0 + 4);
            float r[8];
#pragma unroll
            for (int j = 0; j < 8; ++j) r[j] = y[j] * rstd * (j < 4 ? g0[j] : g1[j - 4]) * z[j] * sigm(z[j]);
            v4u q; q.x = pk2(r[0], r[1]); q.y = pk2(r[2], r[3]); q.z = pk2(r[4], r[5]); q.w = pk2(r[6], r[7]);
            *(v4u*)(cat + (size_t)row * 4096 + 2048 + e0) = q;
        }
    }
}

__device__ __forceinline__ void final_phase(const Args& a, int bid, int nblk) {
    const int lane = threadIdx.x & 63, w = threadIdx.x >> 6;
    const int gw = bid * 8 + w, NGW = nblk * 8;
    const float* part = (const float*)(a.ws + WS_PART); const float* fw = a.in[11];
    for (int row = gw; row < MTOK; row += NGW) {
        const float ps = lane < 32 ? part[(size_t)row * 32 + lane] : 0.f;
        const float rstd = __builtin_amdgcn_rsqf(wave_sum(ps) * (1.f / 2048.f) + EPSV);
        f32x4* o = (f32x4*)(a.out + (size_t)row * 2048) + lane;
#pragma unroll
        for (int j = 0; j < 8; ++j) { const f32x4 g = *((const f32x4*)fw + lane + 64 * j); f32x4 v = o[64 * j]; v.x *= rstd * g.x; v.y *= rstd * g.y; v.z *= rstd * g.z; v.w *= rstd * g.w; o[64 * j] = v; }
    }
}

#define RLX_AGENT __ATOMIC_RELAXED, __HIP_MEMORY_SCOPE_AGENT
#define XB_TMO      128
#define XB_XCNT(j)  (256  + 64 * (j))
#define XB_XSUB(j)  (1280 + 64 * (j))
#define XB_XGEN(j)  (2304 + 64 * (j))
#define XB_TOP      3328
#define XB_TOPGEN   3392
#define XCD_BAR_WORDS 3456
#define XB_SPIN_CAP (1u << 18)

__device__ __forceinline__ unsigned xb_ld(unsigned* p)              { return __hip_atomic_load(p, __ATOMIC_RELAXED, __HIP_MEMORY_SCOPE_AGENT); }
__device__ __forceinline__ unsigned xb_add(unsigned* p, unsigned v) { return __hip_atomic_fetch_add(p, v, __ATOMIC_RELAXED, __HIP_MEMORY_SCOPE_AGENT); }
__device__ __forceinline__ unsigned xb_xcc_id() { return (unsigned)__builtin_amdgcn_s_getreg((3 << 11) | 20) & 0xFu; }
#define XB_SPIN(cond, bar) do { unsigned _sp = 0; while (cond) { __builtin_amdgcn_s_sleep(1); \
    if ((++_sp & 255u) == 0u) { if (xb_ld(&(bar)[XB_TMO])) break; if (_sp > XB_SPIN_CAP) { atomicAdd(&(bar)[XB_TMO], 1u); break; } } } } while (0)

struct XcdBarrier {
    unsigned* bar; unsigned x;
    volatile LAS unsigned* st;
};

__device__ __forceinline__ XcdBarrier xcd_barrier_post(unsigned* bar, volatile LAS unsigned* st) {
    XcdBarrier b; b.bar = bar; b.x = xb_xcc_id(); b.st = st;
    if (threadIdx.x == 0) (void)xb_add(&bar[XB_XCNT(b.x)], 1u);
    return b;
}
__device__ __forceinline__ void xcd_barrier_complete(unsigned* bar, unsigned x, unsigned& nloc, unsigned& nx) {
    const unsigned G = gridDim.x * gridDim.y * gridDim.z;
    unsigned sum, cnt, mine, sp = 0u;
    for (;;) {
        sum = 0u; cnt = 0u; mine = 0u;
#pragma unroll
        for (unsigned j = 0; j < 16; ++j) { const unsigned c = xb_ld(&bar[XB_XCNT(j)]); sum += c; cnt += (c > 0u) ? 1u : 0u; mine = (j == x) ? c : mine; }
        if (sum == G) break;
        __builtin_amdgcn_s_sleep(1);
        if ((++sp & 255u) == 0u) { if (xb_ld(&bar[XB_TMO])) break; if (sp > XB_SPIN_CAP) { atomicAdd(&bar[XB_TMO], 1u); break; } }
    }
    nloc = mine > 0u ? mine : 1u; nx = cnt > 0u ? cnt : 1u;
}

__device__ __forceinline__ void xcd_barrier(const XcdBarrier& b) {
    asm volatile("s_waitcnt vmcnt(0)" ::: "memory");
    __syncthreads();
    if (threadIdx.x == 0) {
        unsigned* bar = b.bar;
        __builtin_amdgcn_s_waitcnt(0);
        unsigned nloc = b.st[0], nx = b.st[1];
        if (nloc == 0u) { xcd_barrier_complete(bar, b.x, nloc, nx); b.st[0] = nloc; b.st[1] = nx; }
        const unsigned old = xb_add(&bar[XB_XSUB(b.x)], 1u);
        const unsigned gen = old / nloc;
        if (old + 1u == (gen + 1u) * nloc) {
            __builtin_amdgcn_fence(__ATOMIC_RELEASE, "agent");
            asm volatile("s_waitcnt vmcnt(0)" ::: "memory");
            const unsigned og = xb_add(&bar[XB_TOP], 1u);
            const unsigned tg = og / nx;
            if (og + 1u == (tg + 1u) * nx) xb_add(&bar[XB_TOPGEN], 1u);
            else XB_SPIN(xb_ld(&bar[XB_TOPGEN]) == tg, bar);
            __builtin_amdgcn_fence(__ATOMIC_ACQUIRE, "agent");
            xb_add(&bar[XB_XGEN(b.x)], 1u);
            asm volatile("s_waitcnt vmcnt(0)" ::: "memory");
        } else {
            XB_SPIN(xb_ld(&bar[XB_XGEN(b.x)]) == gen, bar);
            __builtin_amdgcn_fence(__ATOMIC_ACQUIRE, "agent");
            asm volatile("s_waitcnt vmcnt(0)" ::: "memory");
        }
    }
    __syncthreads();
}

constexpr int NPHASE = 7;
__global__ void __launch_bounds__(512, 2) hymba_fwd(Args a) {
    extern __shared__ __attribute__((aligned(16))) unsigned char shm[];
    LAS unsigned char* lds = (LAS unsigned char*)shm;
    cg::grid_group grid = cg::this_grid();
    const int bid = blockIdx.x, nblk = gridDim.x;
    unsigned char* ws = a.ws;
#if MK_LAUNCHES == 1
    if (threadIdx.x < 16) ((volatile LAS unsigned*)(lds + MISC_OFF))[threadIdx.x] = 0u;
    __syncthreads();
    XcdBarrier bar = xcd_barrier_post((unsigned*)(ws + WS_CTL), (volatile LAS unsigned*)(lds + MISC_OFF));
    if (a.ph_hi == 0x7fffffff) grid.sync();
#define IN(k) true
#define SEAM() xcd_barrier(bar)
#else
    const int lo = a.ph_lo, hi = a.ph_hi;
#define IN(k) (lo <= (k) && (k) < hi)
#define SEAM() do {} while (0)
#endif
    if (TSPH == 0 && bid == 0 && threadIdx.x == 0) ((unsigned long long*)(ws + WS_CTL + 32768))[0] = __builtin_amdgcn_s_memrealtime();
    if (IN(0)) { if (PHM & 1) prep_phase(lds, a, bid, nblk); SEAM(); if (REP & 1) { prep_phase(lds, a, bid, nblk); SEAM(); } }
    if (TSPH == 0 && bid == 0 && threadIdx.x == 0) ((unsigned long long*)(ws + WS_CTL + 32768))[1] = __builtin_amdgcn_s_memrealtime();
    if (TSPH == 1 && bid == 0 && threadIdx.x == 0) ((unsigned long long*)(ws + WS_CTL + 32768))[0] = __builtin_amdgcn_s_memrealtime();
    if (IN(1)) { if (PHM & 2) {
            pg8::Gemm g; g.A = (const bf16_t*)(ws + WS_HN); g.Bt = (const bf16_t*)(ws + WS_WIN); g.M = MTOK; g.N = NIN; g.K = DM;
            pg8::StaticOrder S; S.init(g.M, g.N, nblk, bid); pg8::EpiProj E; E.O = (bf16_t*)(ws + WS_PROJ); E.LBO = a.in[4];
            pg8::gemm_phase<pg8::EpiProj, pg8::StaticOrder, true, true>(lds, g, S, E); }
        SEAM(); }
    if (REP & 2) { if (PHM & 2) {
            pg8::Gemm g; g.A = (const bf16_t*)(ws + WS_HN); g.Bt = (const bf16_t*)(ws + WS_WIN); g.M = MTOK; g.N = NIN; g.K = DM;
            pg8::StaticOrder S; S.init(g.M, g.N, nblk, bid); pg8::EpiProj E; E.O = (bf16_t*)(ws + WS_PROJ); E.LBO = a.in[4];
            pg8::gemm_phase<pg8::EpiProj, pg8::StaticOrder, true, true>(lds, g, S, E); }
        SEAM(); }
    if (TSPH == 1 && bid == 0 && threadIdx.x == 0) ((unsigned long long*)(ws + WS_CTL + 32768))[1] = __builtin_amdgcn_s_memrealtime();
    if (TSPH == 2 && bid == 0 && threadIdx.x == 0) ((unsigned long long*)(ws + WS_CTL + 32768))[0] = __builtin_amdgcn_s_memrealtime();
    if (IN(2)) { if (PHM & 4) hgrn_phase(lds, a, bid, nblk); SEAM(); if (REP & 4) { hgrn_phase(lds, a, bid, nblk); SEAM(); } }
    if (TSPH == 2 && bid == 0 && threadIdx.x == 0) ((unsigned long long*)(ws + WS_CTL + 32768))[1] = __builtin_amdgcn_s_memrealtime();
    if (TSPH == 3 && bid == 0 && threadIdx.x == 0) ((unsigned long long*)(ws + WS_CTL + 32768))[0] = __builtin_amdgcn_s_memrealtime();
    if (IN(3)) { if (PHM & 8) mix_phase(lds, a, bid, nblk); SEAM(); if (REP & 8) { mix_phase(lds, a, bid, nblk); SEAM(); } }
    if (TSPH == 3 && bid == 0 && threadIdx.x == 0) ((unsigned long long*)(ws + WS_CTL + 32768))[1] = __builtin_amdgcn_s_memrealtime();
    if (TSPH == 4 && bid == 0 && threadIdx.x == 0) ((unsigned long long*)(ws + WS_CTL + 32768))[0] = __builtin_amdgcn_s_memrealtime();
    if (IN(4)) { if (PHM & 16) {
            pg8::Gemm g; g.A = (const bf16_t*)(ws + WS_CAT); g.Bt = (const bf16_t*)(ws + WS_WOUT); g.M = MTOK; g.N = DM; g.K = DMIX;
            pg8::StaticOrder S; S.init(g.M, g.N, nblk, bid); pg8::EpiH E; E.X = a.in[0]; E.H = (float*)(ws + WS_H); E.HB = (bf16_t*)(ws + WS_HB);
            pg8::gemm_phase<pg8::EpiH, pg8::StaticOrder, false, true>(lds, g, S, E); }
        SEAM(); }
    if (REP & 16) { if (PHM & 16) {
            pg8::Gemm g; g.A = (const bf16_t*)(ws + WS_CAT); g.Bt = (const bf16_t*)(ws + WS_WOUT); g.M = MTOK; g.N = DM; g.K = DMIX;
            pg8::StaticOrder S; S.init(g.M, g.N, nblk, bid); pg8::EpiH E; E.X = a.in[0]; E.H = (float*)(ws + WS_H); E.HB = (bf16_t*)(ws + WS_HB);
            pg8::gemm_phase<pg8::EpiH, pg8::StaticOrder, false, true>(lds, g, S, E); }
        SEAM(); }
    if (TSPH == 4 && bid == 0 && threadIdx.x == 0) ((unsigned long long*)(ws + WS_CTL + 32768))[1] = __builtin_amdgcn_s_memrealtime();
    if (TSPH == 5 && bid == 0 && threadIdx.x == 0) ((unsigned long long*)(ws + WS_CTL + 32768))[0] = __builtin_amdgcn_s_memrealtime();
    if (IN(5)) {
        if (PHM & 32) {   pg8::Gemm g; g.A = (const bf16_t*)(ws + WS_PB); g.Bt = (const bf16_t*)(ws + WS_WP); g.M = MTOK; g.N = DM; g.K = PLED;
            pg8::StaticOrder S; S.init(g.M, g.N, nblk, bid); pg8::EpiPle E; E.O = (bf16_t*)(ws + WS_OF);
            pg8::gemm_phase<pg8::EpiPle, pg8::StaticOrder, false, true>(lds, g, S, E); }
        if (PHM & 64) {   pg8::Gemm g; g.A = (const bf16_t*)(ws + WS_HB); g.Bt = (const bf16_t*)(ws + WS_WG); g.M = MTOK; g.N = DM; g.K = DM;
            pg8::StaticOrder S; S.init(g.M, g.N, nblk, bid); pg8::EpiGateNorm E; E.HBF = (const bf16_t*)(ws + WS_HB); E.PL = (const bf16_t*)(ws + WS_OF); E.O = a.out; E.XS = (float*)(ws + WS_PART);
            E.CNT = (unsigned*)(ws + WS_CTL + 16384); E.FW = a.in[11];
            pg8::gemm_phase<pg8::EpiGateNorm, pg8::StaticOrder, false, true>(lds, g, S, E); }
    }
    if (TSPH >= 0 && TSPH < 6) { __syncthreads(); if (bid == 0 && threadIdx.x == 0) { const unsigned long long* tsp = (const unsigned long long*)(ws + WS_CTL + 32768); a.out[0] = (float)(tsp[1] - tsp[0]) * 0.01f; } }
}

extern "C" void kernel_launch(void* const* d_in, const int* in_sizes, int n_in, void* d_out, int out_size, void* d_ws, size_t ws_size, hipStream_t stream) {
    static int grid = 0;
    if (grid == 0) {
        if (n_in != 12 || out_size != MTOK * DM || ws_size < WS_END) { fprintf(stderr, "kernel_launch: unexpected shapes (n_in %d out %d ws %zu)\n", n_in, out_size, ws_size); grid = -1; return; }
        int dev = 0, cus = 0, per_cu = 0;
        hipGetDevice(&dev); hipDeviceGetAttribute(&cus, hipDeviceAttributeMultiprocessorCount, dev);
        if (hipFuncSetAttribute((const void*)hymba_fwd, hipFuncAttributeMaxDynamicSharedMemorySize, LDS_BYTES) != hipSuccess) { fprintf(stderr, "kernel_launch: hipFuncSetAttribute failed\n"); grid = -1; return; }
        if (hipOccupancyMaxActiveBlocksPerMultiprocessor(&per_cu, (const void*)hymba_fwd, 512, LDS_BYTES) != hipSuccess || per_cu < 1) { fprintf(stderr, "kernel_launch: occupancy query failed (%d)\n", per_cu); (void)hipGetLastError(); per_cu = 1; }
        grid = cus * (per_cu > 1 ? 1 : per_cu);
        if (grid != 256) fprintf(stderr, "kernel_launch: grid %d != 256: the fused final norm needs one GEMM3 unit per workgroup\n", grid);
        if (grid <= 0) grid = 256;
    }
    if (grid < 0) return;
    Args a{};
    if (hipMemsetAsync((char*)d_ws + WS_CTL, 0, 32768, stream) != hipSuccess) { fprintf(stderr, "kernel_launch: memset failed\n"); return; }
    for (int i = 0; i < 12; ++i) a.in[i] = (const float*)d_in[i];
    a.out = (float*)d_out; a.ws = (unsigned char*)d_ws;
#if MK_LAUNCHES == 1
    a.ph_lo = 0; a.ph_hi = NPHASE;
    void* args[] = {&a};
    hipError_t e = hipLaunchCooperativeKernel((const void*)hymba_fwd, dim3(grid), dim3(512), args, LDS_BYTES, stream);
    if (e != hipSuccess) fprintf(stderr, "cooperative launch failed: %s (grid %d)\n", hipGetErrorString(e), grid);
#else
    for (int ph = 0; ph < NPHASE; ++ph) { a.ph_lo = ph; a.ph_hi = ph + 1; hipLaunchKernelGGL(hymba_fwd, dim3(grid), dim3(512), LDS_BYTES, stream, a); }
#endif
}
```

```cpp
#include <hip/hip_runtime.h>
#include <hip/hip_cooperative_groups.h>
#include <cstdio>
#include <cstdint>
namespace cg = cooperative_groups;
#ifndef TSPH
#define TSPH -1
#endif
#ifndef REP
#define REP 0
#endif
#ifndef PHM
#define PHM 255
#endif
#ifndef MK_LAUNCHES
#define MK_LAUNCHES 1
#endif
namespace pg8 {
#define PG8_LAS __attribute__((address_space(3)))
typedef unsigned short bf16_t;
typedef short bf16x8 __attribute__((ext_vector_type(8)));
typedef float f32x4 __attribute__((ext_vector_type(4)));
typedef unsigned u32x4 __attribute__((ext_vector_type(4)));
constexpr int BM = 256, BK = 64, HALF = 128, HTB = HALF * BK * 2  , STAGE_BYTES = 8 * HTB, NXCD = 8, WGM = 4;

__host__ __device__ __forceinline__ int lds_byte(int r, int c) { const int st = (r >> 4) * 2 + (c >> 5), rr = r & 15, cc = c & 31, ob = rr * 64 + cc * 2; return st * 1024 + (ob ^ (((ob >> 9) & 1) << 5)); }
__host__ __device__ __forceinline__ void stage_rc(int b, int& R, int& C) { const int st = b / 1024, sb = b % 1024, swz = sb ^ (((sb >> 9) & 1) << 5); R = (st >> 1) * 16 + swz / 64; C = (st & 1) * 32 + (swz % 64) / 2; }
__host__ __device__ __forceinline__ int perm32(int rho) { const int n = rho >> 4, i = rho & 15; return 8 * (i >> 2) + 4 * n + (i & 3); }

struct Unit { int pm, pn; };
struct Gemm { const bf16_t* A; const bf16_t* Bt; int M, N, K; };

struct StaticOrder {
    int nM, nN, nwg, G, c;
    __host__ __device__ void init(int M, int N, int G_, int c_) { nM = M / BM; nN = N / BM; nwg = nM * nN; G = G_; c = c_; }
    __host__ __device__ bool next(int i, Unit& u) const {
        const long L = (long)i * G + c; if (L >= nwg) return false;
        int wgid = (int)L; { const int q = nwg / NXCD, r = nwg % NXCD, xcd = wgid % NXCD, off = wgid / NXCD; wgid = (xcd < r ? xcd * (q + 1) : r * (q + 1) + (xcd - r) * q) + off; }
        const int nig = WGM * nN, gid = wgid / nig, fm = gid * WGM, gsz = (nM - fm) < WGM ? (nM - fm) : WGM;
        u.pm = fm + ((wgid % nig) % gsz); u.pn = (wgid % nig) / gsz; return true;
    }
    __device__ __forceinline__ void a_ready(const Unit&) const {}
    __device__ __forceinline__ void done(const Unit&) const {}
};

typedef __bf16 bf16x2n_t __attribute__((ext_vector_type(2)));
typedef float f32x2n_t __attribute__((ext_vector_type(2)));
__device__ __forceinline__ unsigned cvt_pk_bf16(float lo, float hi) { f32x2n_t v; v.x = lo; v.y = hi; const bf16x2n_t r = __builtin_convertvector(v, bf16x2n_t); return __builtin_bit_cast(unsigned, r); }
typedef float f32x2 __attribute__((ext_vector_type(2)));
__device__ __forceinline__ float sigmoidf_fast(float v) { return __builtin_amdgcn_rcpf(1.0f + __builtin_amdgcn_exp2f(-1.44269504f * v)); }

constexpr size_t SECN = (size_t)8192 * 2048;
struct EpiProj {
    static constexpr bool PERM = true, AFTER_DRAIN = false;
    bf16_t* O; const float* LBO;
    __device__ __forceinline__ void operator()(const f32x4 (&acc)[2][2][4][2], const Unit& u, int wr, int wc, int fr, int fq) const {
        const int row0 = u.pm * BM + wr * 64 + fr; int colt = u.pn * BM; const int sec = colt >> 11; colt -= sec << 11;
        if (sec == 6 || sec == 7) {
            bf16_t* ub = O + (size_t)6 * SECN + (u.pn - 48) * 128 + wc * 32 + 8 * fq;
#pragma unroll
            for (int ai = 0; ai < 2; ++ai)
#pragma unroll
                for (int m = 0; m < 4; ++m) { const f32x4 v0 = acc[ai][0][m][0] * acc[ai][1][m][0], v1 = acc[ai][0][m][1] * acc[ai][1][m][1];
                    u32x4 w; w.x = cvt_pk_bf16(v0[0], v0[1]); w.y = cvt_pk_bf16(v0[2], v0[3]); w.z = cvt_pk_bf16(v1[0], v1[1]); w.w = cvt_pk_bf16(v1[2], v1[3]);
                    *(u32x4*)(ub + (size_t)(row0 + ai * HALF + m * 16) * 2048) = w; }
            return; }
        bf16_t* base = O + (size_t)sec * SECN; const int col0 = colt + wc * 32 + 8 * fq;
        f32x4 oml[2][2];
#pragma unroll
        for (int bj = 0; bj < 2; ++bj)
#pragma unroll
            for (int n = 0; n < 2; ++n) { oml[bj][n] = (f32x4){0.f, 0.f, 0.f, 0.f};
                if (sec == 2 || sec == 3) { const float* tp = LBO + (sec - 2) * 4096 + col0 + bj * HALF + 4 * n; const f32x4 t0 = *(const f32x4*)(tp), t1 = *(const f32x4*)(tp + 2048);
#pragma unroll
                    for (int j = 0; j < 4; ++j) oml[bj][n][j] = sigmoidf_fast(t1[j] - t0[j]); } }
#pragma unroll
        for (int ai = 0; ai < 2; ++ai)
#pragma unroll
            for (int m = 0; m < 4; ++m) { const int r = row0 + ai * HALF + m * 16; bf16_t* rowp = base + (unsigned)(r * 2048 + col0);
                bf16_t* hrow = base + (unsigned)((((r >> 11) * 16 + (colt >> 7)) * 2048 + (r & 2047)) * 128 + wc * 32 + 8 * fq);
#pragma unroll
                for (int bj = 0; bj < 2; ++bj) { f32x4 v0 = acc[ai][bj][m][0], v1 = acc[ai][bj][m][1];
                    if (sec == 0) {
#pragma unroll
                        for (int j = 0; j < 4; ++j) { v0[j] = v0[j] * sigmoidf_fast(v0[j]); v1[j] = v1[j] * sigmoidf_fast(v1[j]); } }
                    if (sec == 2 || sec == 3) {
#pragma unroll
                        for (int j = 0; j < 4; ++j) { v0[j] = oml[bj][0][j] * sigmoidf_fast(-v0[j]); v1[j] = oml[bj][1][j] * sigmoidf_fast(-v1[j]); } }
                    u32x4 w; w.x = cvt_pk_bf16(v0[0], v0[1]); w.y = cvt_pk_bf16(v0[2], v0[3]); w.z = cvt_pk_bf16(v1[0], v1[1]); w.w = cvt_pk_bf16(v1[2], v1[3]);
                    if (sec < 4) *(u32x4*)(hrow + (size_t)bj * 2048 * 128) = w; else *(u32x4*)(rowp + bj * HALF) = w; } }
    }
};
struct EpiH {
    static constexpr bool PERM = true, AFTER_DRAIN = false;
    const float* X; float* H; bf16_t* HB;
    __device__ __forceinline__ void operator()(const f32x4 (&acc)[2][2][4][2], const Unit& u, int wr, int wc, int fr, int fq) const {
        const int row0 = u.pm * BM + wr * 64 + fr; const int col0 = u.pn * BM + wc * 32 + 8 * fq;
#pragma unroll
        for (int ai = 0; ai < 2; ++ai)
#pragma unroll
            for (int m = 0; m < 4; ++m) { const size_t off = (size_t)(row0 + ai * HALF + m * 16) * 2048 + col0;
#pragma unroll
                for (int bj = 0; bj < 2; ++bj) { const f32x4 x0 = __builtin_nontemporal_load((const f32x4*)(X + off + bj * HALF)), x1 = __builtin_nontemporal_load((const f32x4*)(X + off + bj * HALF + 4));
                    const f32x4 v0 = acc[ai][bj][m][0] + x0, v1 = acc[ai][bj][m][1] + x1;
                    u32x4 w; w.x = cvt_pk_bf16(v0[0], v0[1]); w.y = cvt_pk_bf16(v0[2], v0[3]); w.z = cvt_pk_bf16(v1[0], v1[1]); w.w = cvt_pk_bf16(v1[2], v1[3]);
                    *(u32x4*)(HB + off + bj * HALF) = w; } }
    }
};
struct EpiPle {
    static constexpr bool PERM = true, AFTER_DRAIN = false;
    bf16_t* O;
    __device__ __forceinline__ void operator()(const f32x4 (&acc)[2][2][4][2], const Unit& u, int wr, int wc, int fr, int fq) const {
        const int row0 = u.pm * BM + wr * 64 + fr; const int col0 = u.pn * BM + wc * 32 + 8 * fq;
#pragma unroll
        for (int ai = 0; ai < 2; ++ai)
#pragma unroll
            for (int m = 0; m < 4; ++m) { const size_t off = (size_t)(row0 + ai * HALF + m * 16) * 2048 + col0;
#pragma unroll
                for (int bj = 0; bj < 2; ++bj) { const f32x4 v0 = acc[ai][bj][m][0], v1 = acc[ai][bj][m][1];
                    u32x4 w; w.x = cvt_pk_bf16(v0[0], v0[1]); w.y = cvt_pk_bf16(v0[2], v0[3]); w.z = cvt_pk_bf16(v1[0], v1[1]); w.w = cvt_pk_bf16(v1[2], v1[3]);
                    *(u32x4*)(O + off + bj * HALF) = w; } }
    }
};
struct EpiGateNorm {
    static constexpr bool PERM = true, AFTER_DRAIN = true;
    const bf16_t* HBF; const bf16_t* PL; float* O; float* XS; unsigned* CNT; const float* FW;
    __device__ __forceinline__ void operator()(const f32x4 (&)[2][2][4][2], const Unit&, int, int, int, int) const {}
    __device__ __forceinline__ void fused(f32x4 (&acc)[2][2][4][2], const Unit& u, int wr, int wc, int fr, int fq, PG8_LAS unsigned char* lds, int wid, int lane) const {
        PG8_LAS float* PS = (PG8_LAS float*)lds; PG8_LAS float* RS = (PG8_LAS float*)(lds + 4096);
        const int row0 = u.pm * BM + wr * 64 + fr; const int col0 = u.pn * BM + wc * 32 + 8 * fq;
#pragma unroll
        for (int ai = 0; ai < 2; ++ai)
#pragma unroll
            for (int m = 0; m < 4; ++m) { const int row = row0 + ai * HALF + m * 16; const size_t off = (size_t)row * 2048 + col0; float ss = 0.f;
#pragma unroll
                for (int bj = 0; bj < 2; ++bj) {
                    const u32x4 hw = *(const u32x4*)(HBF + off + bj * HALF);
                    const f32x4 h0 = (f32x4){__uint_as_float(hw.x << 16), __uint_as_float(hw.x & 0xffff0000u), __uint_as_float(hw.y << 16), __uint_as_float(hw.y & 0xffff0000u)};
                    const f32x4 h1 = (f32x4){__uint_as_float(hw.z << 16), __uint_as_float(hw.z & 0xffff0000u), __uint_as_float(hw.w << 16), __uint_as_float(hw.w & 0xffff0000u)};
                    const u32x4 pw = *(const u32x4*)(PL + off + bj * HALF);
                    const f32x4 p0 = (f32x4){__uint_as_float(pw.x << 16), __uint_as_float(pw.x & 0xffff0000u), __uint_as_float(pw.y << 16), __uint_as_float(pw.y & 0xffff0000u)};
                    const f32x4 p1 = (f32x4){__uint_as_float(pw.z << 16), __uint_as_float(pw.z & 0xffff0000u), __uint_as_float(pw.w << 16), __uint_as_float(pw.w & 0xffff0000u)};
                    f32x4 v0, v1;
#pragma unroll
                    for (int j = 0; j < 4; ++j) { v0[j] = h0[j] + p0[j] * sigmoidf_fast(acc[ai][bj][m][0][j]); v1[j] = h1[j] + p1[j] * sigmoidf_fast(acc[ai][bj][m][1][j]);
                        ss += v0[j] * v0[j] + v1[j] * v1[j]; }
                    acc[ai][bj][m][0] = v0; acc[ai][bj][m][1] = v1; }
                ss += __shfl_xor(ss, 16); ss += __shfl_xor(ss, 32);
                if (fq == 0) PS[(ai * HALF + wr * 64 + m * 16 + fr) * 4 + wc] = ss; }
        asm volatile("s_waitcnt lgkmcnt(0)" ::: "memory"); __builtin_amdgcn_s_barrier(); asm volatile("" ::: "memory");
        const int tid = wid * 64 + lane;
        if (tid < 256) { const f32x4 p = *(const PG8_LAS f32x4*)(PS + tid * 4);
            __hip_atomic_store(XS + (size_t)(u.pm * 256 + tid) * 8 + u.pn, (p[0] + p[1]) + (p[2] + p[3]), __ATOMIC_RELAXED, __HIP_MEMORY_SCOPE_AGENT); }
        asm volatile("s_waitcnt vmcnt(0)" ::: "memory"); __builtin_amdgcn_s_barrier(); asm volatile("" ::: "memory");
        if (tid == 0) { unsigned* c = CNT + 64 * u.pm; __hip_atomic_fetch_add(c, 1u, __ATOMIC_RELAXED, __HIP_MEMORY_SCOPE_AGENT);
            unsigned sp = 0; while (__hip_atomic_load(c, __ATOMIC_RELAXED, __HIP_MEMORY_SCOPE_AGENT) < 8u) { __builtin_amdgcn_s_sleep(1); if (++sp > (1u << 20)) break; } }
        asm volatile("" ::: "memory"); __builtin_amdgcn_s_barrier(); asm volatile("" ::: "memory");
        if (tid < 256) { const float* x = XS + (size_t)(u.pm * 256 + tid) * 8; float s = 0.f;
#pragma unroll
            for (int k = 0; k < 8; ++k) s += __hip_atomic_load(x + k, __ATOMIC_RELAXED, __HIP_MEMORY_SCOPE_AGENT);
            RS[tid] = __builtin_amdgcn_rsqf(s * (1.f / 2048.f) + 1e-6f); }
        asm volatile("s_waitcnt lgkmcnt(0)" ::: "memory"); __builtin_amdgcn_s_barrier(); asm volatile("" ::: "memory");
        f32x4 fw[2][2];
#pragma unroll
        for (int bj = 0; bj < 2; ++bj) { fw[bj][0] = *(const f32x4*)(FW + col0 + bj * HALF); fw[bj][1] = *(const f32x4*)(FW + col0 + bj * HALF + 4); }
#pragma unroll
        for (int ai = 0; ai < 2; ++ai)
#pragma unroll
            for (int m = 0; m < 4; ++m) { const int rl = ai * HALF + wr * 64 + m * 16 + fr; const float rstd = RS[rl]; const size_t off = (size_t)(u.pm * BM + rl) * 2048 + col0;
#pragma unroll
                for (int bj = 0; bj < 2; ++bj) { __builtin_nontemporal_store(acc[ai][bj][m][0] * rstd * fw[bj][0], (f32x4*)(O + off + bj * HALF)); __builtin_nontemporal_store(acc[ai][bj][m][1] * rstd * fw[bj][1], (f32x4*)(O + off + bj * HALF + 4)); } }
    }
};

template <class Epi, class Sched, bool ALIGN_EPI = false, bool SP2 = false>
__device__ __forceinline__ void gemm_phase(PG8_LAS unsigned char* lds, const Gemm g, const Sched& S, const Epi& E) {
    int tid_ = threadIdx.x; asm volatile("" : "+v"(tid_));
    const int tid = tid_, wid = __builtin_amdgcn_readfirstlane(tid >> 6), lane = tid & 63, wr = wid >> 2, wc = wid & 3, fr = lane & 15, fq = lane >> 4;
    const int K = g.K, nt = K / BK;
    unsigned voffA[2], voffB[2];
#pragma unroll
    for (int i = 0; i < 2; ++i) { int R, C; stage_rc(tid * 16 + i * 8192, R, C); const int Rb = Epi::PERM ? ((R & ~31) + perm32(R & 31)) : R;
        voffA[i] = (unsigned)(R * K + C) * 2u; voffB[i] = (unsigned)(Rb * K + C) * 2u; }
    const size_t kstep = (size_t)(BK * 2);
    const size_t hstep = (size_t)HALF * K * 2;
    const size_t tstep = 2 * hstep;
    const unsigned ldsw = (unsigned)wid * 1024u;
    const int aoff = lds_byte(wr * 64 + fr, fq * 8), boff = lds_byte(wc * 32 + fr, fq * 8);
#define PG8_SA(b, h) (((b) * 2 + (h)) * HTB)
#define PG8_SB(b, h) ((4 + (b) * 2 + (h)) * HTB)
#define PG8_STAGE(bufoff, gbase, voff) do { _Pragma("unroll") for (int _i = 0; _i < 2; ++_i) \
        __builtin_amdgcn_global_load_lds((const unsigned*)((const char*)(gbase) + (voff)[_i]), (PG8_LAS unsigned*)(lds + (bufoff) + ldsw + _i * 8192), 16, 0, 0); } while (0)
#define PG8_LDA(dst, b, h) do { _Pragma("unroll") for (int m = 0; m < 4; ++m) _Pragma("unroll") for (int k = 0; k < 2; ++k) dst[m][k] = *(const PG8_LAS bf16x8*)(lds + PG8_SA(b, h) + aoff + m * 2048 + k * 1024); } while (0)
#define PG8_LDB(dst, b, h) do { _Pragma("unroll") for (int n = 0; n < 2; ++n) _Pragma("unroll") for (int k = 0; k < 2; ++k) dst[n][k] = *(const PG8_LAS bf16x8*)(lds + PG8_SB(b, h) + boff + n * 2048 + k * 1024); } while (0)
#define PG8_MMA(ai, bj, At, Bt) do { __builtin_amdgcn_s_setprio(1); _Pragma("unroll") for (int m = 0; m < 4; ++m) _Pragma("unroll") for (int n = 0; n < 2; ++n) _Pragma("unroll") for (int k = 0; k < 2; ++k) \
        acc[ai][bj][m][n] = __builtin_amdgcn_mfma_f32_16x16x32_bf16(Bt[n][k], At[m][k], acc[ai][bj][m][n], 0, 0, 0); __builtin_amdgcn_s_setprio(0); } while (0)
#define PG8_WAIT_V(n) asm volatile("s_waitcnt vmcnt(" #n ")" ::: "memory")
#define PG8_WAIT_L(n) asm volatile("s_waitcnt lgkmcnt(" #n ")" ::: "memory")
#define PG8_BAR __builtin_amdgcn_s_barrier()
#define PG8_SCHED __builtin_amdgcn_sched_barrier(0)
    Unit cur, nxt; int ui = 0;
    if (!S.next(0, cur)) return;
    f32x4 acc[2][2][4][2];
#pragma unroll
    for (int a = 0; a < 2; ++a)
#pragma unroll
        for (int b = 0; b < 2; ++b)
#pragma unroll
            for (int m = 0; m < 4; ++m)
#pragma unroll
                for (int n = 0; n < 2; ++n) acc[a][b][m][n] = (f32x4){0.f, 0.f, 0.f, 0.f};
    bf16x8 At[4][2], B0[2][2], B1[2][2];
    const char* cA = (const char*)g.A + (size_t)cur.pm * tstep; const char* cB = (const char*)g.Bt + (size_t)cur.pn * tstep;
    S.a_ready(cur);
    if constexpr (SP2) {
        PG8_STAGE(PG8_SB(0, 0), cB, voffB); PG8_STAGE(PG8_SB(0, 1), cB + hstep, voffB); PG8_STAGE(PG8_SA(0, 0), cA, voffA); PG8_STAGE(PG8_SA(0, 1), cA + hstep, voffA);
        if (wr == 1) PG8_BAR;
        PG8_WAIT_V(2); PG8_BAR;
        PG8_STAGE(PG8_SB(1, 0), cB + kstep, voffB); PG8_STAGE(PG8_SA(1, 0), cA + kstep, voffA); PG8_STAGE(PG8_SB(1, 1), cB + hstep + kstep, voffB);
        PG8_WAIT_V(6); PG8_BAR;
    } else {
        PG8_STAGE(PG8_SB(0, 0), cB, voffB); PG8_STAGE(PG8_SA(0, 0), cA, voffA); PG8_STAGE(PG8_SB(0, 1), cB + hstep, voffB); PG8_STAGE(PG8_SA(0, 1), cA + hstep, voffA);
        if (wr == 1) PG8_BAR;
        PG8_WAIT_V(4); PG8_BAR;
        PG8_STAGE(PG8_SB(1, 0), cB + kstep, voffB); PG8_STAGE(PG8_SA(1, 0), cA + kstep, voffA); PG8_STAGE(PG8_SB(1, 1), cB + hstep + kstep, voffB);
        PG8_WAIT_V(6); PG8_BAR;
    }
    for (;;) {
        const bool has_next = S.next(ui + 1, nxt);
        const char* nA = has_next ? (const char*)g.A + (size_t)nxt.pm * tstep : cA; const char* nB = has_next ? (const char*)g.Bt + (size_t)nxt.pn * tstep : cB;
        for (int t = 0; t < nt; t += 2) {
            const bool last = (t == nt - 2);
            const char* a1 = cA + (size_t)(t + 1) * kstep;
            const char* a2 = last ? nA : cA + (size_t)(t + 2) * kstep; const char* b2 = last ? nB : cB + (size_t)(t + 2) * kstep;
            const char* a3 = a2 + kstep; const char* b3 = b2 + kstep;
            if (last && has_next) S.a_ready(nxt);
            if constexpr (SP2) {
            PG8_LDB(B0, 0, 0); PG8_LDB(B1, 0, 1); PG8_SCHED; PG8_LDA(At, 0, 0); PG8_STAGE(PG8_SA(1, 1), a1 + hstep, voffA);
            PG8_WAIT_V(8); PG8_WAIT_L(0); PG8_BAR; PG8_MMA(0, 0, At, B0); PG8_MMA(0, 1, At, B1); PG8_BAR; PG8_SCHED;
            PG8_LDA(At, 0, 1); PG8_STAGE(PG8_SB(0, 0), b2, voffB); PG8_STAGE(PG8_SB(0, 1), b2 + hstep, voffB); PG8_STAGE(PG8_SA(0, 0), a2, voffA);
            PG8_WAIT_V(8); PG8_WAIT_L(0); PG8_BAR; PG8_MMA(1, 0, At, B0); PG8_MMA(1, 1, At, B1); PG8_BAR; PG8_SCHED;
            PG8_LDB(B0, 1, 0); PG8_LDB(B1, 1, 1); PG8_SCHED; PG8_LDA(At, 1, 0); PG8_STAGE(PG8_SA(0, 1), a2 + hstep, voffA);
            PG8_WAIT_V(8); PG8_WAIT_L(0); PG8_BAR; PG8_MMA(0, 0, At, B0); PG8_MMA(0, 1, At, B1); PG8_BAR; PG8_SCHED;
            PG8_LDA(At, 1, 1); PG8_STAGE(PG8_SB(1, 0), b3, voffB); PG8_STAGE(PG8_SB(1, 1), b3 + hstep, voffB); PG8_STAGE(PG8_SA(1, 0), a3, voffA);
            PG8_WAIT_V(8); PG8_WAIT_L(0); PG8_BAR; PG8_MMA(1, 0, At, B0); PG8_MMA(1, 1, At, B1); PG8_BAR; PG8_SCHED;
            } else {
            PG8_LDB(B0, 0, 0); PG8_SCHED; PG8_LDA(At, 0, 0); PG8_STAGE(PG8_SA(1, 1), a1 + hstep, voffA);
            PG8_WAIT_L(8); PG8_BAR; PG8_WAIT_L(0); PG8_MMA(0, 0, At, B0); PG8_BAR; PG8_SCHED;
            PG8_LDB(B1, 0, 1); PG8_STAGE(PG8_SB(0, 0), b2, voffB);
            PG8_BAR; PG8_WAIT_L(0); PG8_MMA(0, 1, At, B1); PG8_BAR;
            PG8_LDA(At, 0, 1); PG8_STAGE(PG8_SA(0, 0), a2, voffA);
            PG8_BAR; PG8_WAIT_L(0); PG8_MMA(1, 0, At, B0); PG8_BAR; PG8_SCHED;
            PG8_STAGE(PG8_SB(0, 1), b2 + hstep, voffB);
            PG8_WAIT_V(6); PG8_BAR; PG8_MMA(1, 1, At, B1); PG8_BAR;
            PG8_LDB(B0, 1, 0); PG8_SCHED; PG8_LDA(At, 1, 0); PG8_STAGE(PG8_SA(0, 1), a2 + hstep, voffA);
            PG8_WAIT_L(8); PG8_BAR; PG8_WAIT_L(0); PG8_MMA(0, 0, At, B0); PG8_BAR; PG8_SCHED;
            PG8_LDB(B1, 1, 1); PG8_STAGE(PG8_SB(1, 0), b3, voffB);
            PG8_BAR; PG8_WAIT_L(0); PG8_MMA(0, 1, At, B1); PG8_BAR;
            PG8_LDA(At, 1, 1); PG8_STAGE(PG8_SA(1, 0), a3, voffA);
            PG8_BAR; PG8_WAIT_L(0); PG8_MMA(1, 0, At, B0); PG8_BAR; PG8_SCHED;
            PG8_STAGE(PG8_SB(1, 1), b3 + hstep, voffB);
            PG8_WAIT_V(6); PG8_BAR; PG8_MMA(1, 1, At, B1); PG8_BAR;
            }
        }
        if constexpr (ALIGN_EPI) { if (wr == 0) PG8_BAR; }
        if constexpr (!Epi::AFTER_DRAIN) { E(acc, cur, wr, wc, fr, fq); S.done(cur); }
        if (!has_next) break;
#pragma unroll
        for (int a = 0; a < 2; ++a)
#pragma unroll
            for (int b = 0; b < 2; ++b)
#pragma unroll
                for (int m = 0; m < 4; ++m)
#pragma unroll
                    for (int n = 0; n < 2; ++n) acc[a][b][m][n] = (f32x4){0.f, 0.f, 0.f, 0.f};
        cur = nxt; cA = nA; cB = nB; ++ui;
        if constexpr (ALIGN_EPI) { if (wr == 1) PG8_BAR; }
    }
    PG8_WAIT_V(0);
    if constexpr (!ALIGN_EPI) { if (wr == 0) PG8_BAR; }
    PG8_BAR;
    if constexpr (Epi::AFTER_DRAIN) { E.fused(acc, cur, wr, wc, fr, fq, lds, wid, lane); S.done(cur); }
#undef PG8_SA
#undef PG8_SB
#undef PG8_STAGE
#undef PG8_LDA
#undef PG8_LDB
#undef PG8_MMA
#undef PG8_WAIT_V
#undef PG8_WAIT_L
#undef PG8_BAR
#undef PG8_SCHED
}
}
#define LAS __attribute__((address_space(3)))
typedef unsigned short bf16_t;
typedef unsigned v4u __attribute__((ext_vector_type(4)));
typedef unsigned v2u __attribute__((ext_vector_type(2)));
typedef float f32x4 __attribute__((ext_vector_type(4)));
typedef float f32x2 __attribute__((ext_vector_type(2)));
typedef short bf16x8 __attribute__((ext_vector_type(8)));
constexpr int MTOK = 8192, DM = 2048, NIN = 18432, DMIX = 4096, PLED = 256, SEQL = 2048;
constexpr size_t MiB = (size_t)1 << 20;
constexpr size_t SECN = (size_t)MTOK * 2048;
constexpr size_t WS_WIN = 0, WS_HN = 72 * MiB, WS_WOUT = 104 * MiB, WS_WG = 120 * MiB, WS_WP = 128 * MiB, WS_PB = 129 * MiB;
constexpr size_t WS_PROJ = 136 * MiB, WS_OF = 424 * MiB, WS_PART = 552 * MiB, WS_CTL = 553 * MiB, WS_LBO = WS_CTL + 65536, WS_END = 554 * MiB;
constexpr size_t WS_CAT = WS_PROJ, WS_H = WS_PROJ + 64 * MiB, WS_HB = WS_WIN;
constexpr int MISC_OFF = 156672, LDS_BYTES = MISC_OFF + 64;
constexpr float EPSV = 1e-6f;
#define LDS_WAIT() asm volatile("s_waitcnt lgkmcnt(0)" ::: "memory")

__device__ __forceinline__ unsigned pk2(float lo, float hi) { unsigned r; asm volatile("v_cvt_pk_bf16_f32 %0, %1, %2" : "=v"(r) : "v"(lo), "v"(hi)); return r; }
typedef __bf16 bf16x2_t __attribute__((ext_vector_type(2)));
__device__ __forceinline__ unsigned pk2m(float lo, float hi) { f32x2 v; v.x = lo; v.y = hi; const bf16x2_t r = __builtin_convertvector(v, bf16x2_t); return __builtin_bit_cast(unsigned, r); }
__device__ __forceinline__ float bf_lo(unsigned u) { return __uint_as_float(u << 16); }
__device__ __forceinline__ float bf_hi(unsigned u) { return __uint_as_float(u & 0xffff0000u); }
__device__ __forceinline__ float wave_sum(float v) {
#pragma unroll
    for (int o = 1; o < 64; o <<= 1) v += __shfl_xor(v, o);
    return v;
}
__device__ __forceinline__ float sigm(float v) { return __builtin_amdgcn_rcpf(1.0f + __builtin_amdgcn_exp2f(-1.44269504f * v)); }

struct Args { const float* in[12]; float* out; unsigned char* ws; int ph_lo, ph_hi; };

template <bool REMAP> __device__ __forceinline__ void transpose_item(const float* W, int K, int N, bf16_t* WT, LAS float* scr, int item, int lane) {
    const int nblk = N / 32, kb = item / nblk, nb = item % nblk, k0 = 64 * kb, n0 = 32 * nb;
    int d0 = n0;
    if (REMAP && n0 >= 12288 && n0 < 16384) { const int sec7 = n0 >= 14336, cc = n0 - (sec7 ? 14336 : 12288); d0 = 12288 + (cc >> 7) * 256 + sec7 * 128 + (cc & 127); }
#pragma unroll 8
    for (int i = 0; i < 32; ++i) { const int kk = 2 * i + (lane >> 5); scr[kk * 33 + (lane & 31)] = __builtin_nontemporal_load(&W[(size_t)(k0 + kk) * N + n0 + (lane & 31)]); }
    LDS_WAIT();
    const int c = lane & 7;
#pragma unroll
    for (int j = 0; j < 4; ++j) { const int n = (lane >> 3) + 8 * j; const LAS float* s = scr + (8 * c) * 33 + n;
        v4u o; o.x = pk2(s[0 * 33], s[1 * 33]); o.y = pk2(s[2 * 33], s[3 * 33]); o.z = pk2(s[4 * 33], s[5 * 33]); o.w = pk2(s[6 * 33], s[7 * 33]);
        *(v4u*)(WT + (size_t)(d0 + n) * K + k0 + 8 * c) = o; }
    LDS_WAIT();
}
__device__ __forceinline__ void prep_phase(LAS unsigned char* lds, const Args& a, int bid, int nblk) {
    const int lane = threadIdx.x & 63, w = threadIdx.x >> 6;
    LAS float* scr = (LAS float*)(lds + w * 8704);
    const int gw = bid * 8 + w, NGW = nblk * 8;
    unsigned char* ws = a.ws;
    constexpr int I_IN = (DM / 64) * (NIN / 32), I_OUT = (DMIX / 64) * (DM / 32), I_G = (DM / 64) * (DM / 32), I_P = (PLED / 64) * (DM / 32);
    for (int it = gw; it < I_IN + I_OUT + I_G + I_P; it += NGW) {
        int r = it;
        if (r < I_IN) { transpose_item<true>(a.in[3], DM, NIN, (bf16_t*)(ws + WS_WIN), scr, r, lane); continue; } r -= I_IN;
        if (r < I_OUT) { transpose_item<false>(a.in[8], DMIX, DM, (bf16_t*)(ws + WS_WOUT), scr, r, lane); continue; } r -= I_OUT;
        if (r < I_G) { transpose_item<false>(a.in[10], DM, DM, (bf16_t*)(ws + WS_WG), scr, r, lane); continue; } r -= I_G;
        transpose_item<false>(a.in[9], PLED, DM, (bf16_t*)(ws + WS_WP), scr, r, lane);
    }
    const float* x = a.in[0]; const float* nw = a.in[2]; bf16_t* hn = (bf16_t*)(ws + WS_HN);
    for (int row = gw; row < MTOK; row += NGW) {
        const f32x4* xr = (const f32x4*)(x + (size_t)row * DM) + lane;
        f32x4 v[8]; float s = 0.f;
#pragma unroll
        for (int j = 0; j < 8; ++j) { v[j] = __builtin_nontemporal_load(&xr[64 * j]); s += (v[j].x * v[j].x + v[j].y * v[j].y) + (v[j].z * v[j].z + v[j].w * v[j].w); }
        const float rstd = __builtin_amdgcn_rsqf(wave_sum(s) * (1.f / DM) + EPSV);
        v2u* o = (v2u*)(hn + (size_t)row * DM) + lane;
#pragma unroll
        for (int j = 0; j < 8; ++j) { const f32x4 g = *((const f32x4*)nw + lane + 64 * j);
            v2u q; q.x = pk2(v[j].x * rstd * g.x, v[j].y * rstd * g.y); q.y = pk2(v[j].z * rstd * g.z, v[j].w * rstd * g.w); o[64 * j] = q; }
    }
    const f32x4* p4 = (const f32x4*)a.in[1]; v2u* pb = (v2u*)(ws + WS_PB);
    for (int i = gw * 64 + lane; i < MTOK * PLED / 4; i += NGW * 64) { const f32x4 v = __builtin_nontemporal_load(&p4[i]); v2u q; q.x = pk2(v.x, v.y); q.y = pk2(v.z, v.w); pb[i] = q; }
}

constexpr int SQ = 136, SK = 72;
constexpr int B_QR = 0, B_KR = 17408, B_KRT = 34816, B_VT = 53248, BUF_SZ = 62464;
constexpr int P2_P = 2 * BUF_SZ, P2_ST = P2_P + 9216, P2_SEG = P2_ST + 17408, P2_CH = P2_SEG + 2048;
static_assert(P2_CH + 2 * 1536 <= MISC_OFF, "P2 LDS map");
#define MFMA16(a, b, c) __builtin_amdgcn_mfma_f32_16x16x32_bf16(a, b, c, 0, 0, 0)
#define LBAR() do { asm volatile("s_waitcnt lgkmcnt(0)" ::: "memory"); __builtin_amdgcn_s_barrier(); asm volatile("" ::: "memory"); } while (0)
__device__ __forceinline__ bf16x8 frag(LAS unsigned char* lds, int base, int r0, int ks, int rs, int fr, int fq) { return *(const LAS bf16x8*)(lds + base + ((r0 + fr) * rs + ks * 32 + 8 * fq) * 2); }

template <int DIR> __device__ __forceinline__ void hgrn_item(LAS unsigned char* lds, const Args& a, const bf16_t* proj, int item) {
    const int tid = threadIdx.x, lane = tid & 63, w = __builtin_amdgcn_readfirstlane(tid >> 6), fr = lane & 15, fq = lane >> 4;
    const bool prod = w < 4;
    const int pw = w & 3, cw = w & 3, cp = lane, ptid = pw * 64 + lane, vcp = ptid & 31, sseg = ptid >> 5;
    constexpr int dir = DIR;
    const int vh = item & 1, h = (item >> 2) & 15, b = item >> 6;
    const size_t hb = (size_t)(b * 16 + h) * 2048 * 128;
    const bf16_t* qb = proj + hb; const bf16_t* fb = proj + (size_t)(2 + dir) * SECN + hb; const bf16_t* vb = proj + SECN + hb + vh * 64;
    const unsigned qlo = 2 * cp, vlo = (dir ? 8 * (1 - (lane >> 5)) : 8 * (lane >> 5)) * 128 + 2 * vcp;
    bf16_t* ob = (bf16_t*)(a.ws + WS_OF) + (size_t)item * (2048 * 64);
    const int tokbase = 0;
    for (int i = tid; i < 2304; i += 512) ((LAS unsigned*)(lds + P2_P))[i] = 0u;
    f32x4 S[2][4];
#pragma unroll
    for (int ct = 0; ct < 2; ++ct)
#pragma unroll
        for (int nt = 0; nt < 4; ++nt) S[ct][nt] = (f32x4){0.f, 0.f, 0.f, 0.f};
    unsigned qreg[16], freg[16], vreg[8];
#define P2_LOADK(n, F) do { const int c0 = 64 * (DIR ? 31 - (n) : (n)); \
        const bf16_t* fp_ = fb + (size_t)(DIR ? c0 + 63 - 16 * pw : c0 + 16 * pw) * 128 + qlo; \
        _Pragma("unroll") for (int i = 0; i < 16; ++i) F[i] = *(const unsigned*)(fp_ + (DIR ? -i : i) * 128); } while (0)
#define P2_LOADV(n) do { const int c0 = 64 * (DIR ? 31 - (n) : (n)); \
        const bf16_t* vp_ = vb + (size_t)(DIR ? c0 + 55 - 16 * pw : c0 + 16 * pw) * 128 + vlo; \
        _Pragma("unroll") for (int i = 0; i < 8; ++i) vreg[i] = *(const unsigned*)(vp_ + (DIR ? -i : i) * 128); } while (0)
#define P2_LOADQ(n, Q) do { const int c0 = 64 * (DIR ? 31 - (n) : (n)); \
        const bf16_t* qp_ = qb + (size_t)(DIR ? c0 + 63 - 16 * pw : c0 + 16 * pw) * 128 + qlo; \
        _Pragma("unroll") for (int i = 0; i < 16; ++i) Q[i] = *(const unsigned*)(qp_ + (DIR ? -i : i) * 128); } while (0)
    unsigned knx[16];
    unsigned qnx[16];
    if (prod) { P2_LOADK(0, freg); P2_LOADV(0); P2_LOADQ(0, qreg); }
    for (int step = -1; step < 32; ++step) {
        const int n1 = step + 1;
        if (prod) {
            if (n1 < 32) {
                if (n1 + 1 < 32) { P2_LOADK(n1 + 1, knx); P2_LOADQ(n1 + 1, qnx); }
                f32x2 run = (f32x2){1.f, 1.f};
#pragma unroll
                for (int i = 0; i < 16; ++i) { const f32x2 kv = (f32x2){bf_lo(freg[i]), bf_hi(freg[i])}; run = run * ((f32x2){1.f, 1.f} - kv); }
                *(LAS f32x2*)(lds + P2_SEG + (pw * 128 + 2 * cp) * 4) = run;
                { const int base = (n1 & 1) * BUF_SZ;
#pragma unroll
                for (int e = 0; e < 2; ++e) { v4u t;
                    if (e == 0) { t.x = (vreg[0] & 0xffffu) | (vreg[1] << 16); t.y = (vreg[2] & 0xffffu) | (vreg[3] << 16); t.z = (vreg[4] & 0xffffu) | (vreg[5] << 16); t.w = (vreg[6] & 0xffffu) | (vreg[7] << 16); }
                    else { t.x = (vreg[0] >> 16) | (vreg[1] & 0xffff0000u); t.y = (vreg[2] >> 16) | (vreg[3] & 0xffff0000u); t.z = (vreg[4] >> 16) | (vreg[5] & 0xffff0000u); t.w = (vreg[6] >> 16) | (vreg[7] & 0xffff0000u); }
                    *(LAS v4u*)(lds + base + B_VT + ((2 * vcp + e) * SK + 8 * sseg) * 2) = t; }
                }
                if (n1 + 1 < 32) P2_LOADV(n1 + 1);
            }
        } else if (step >= 0) {
            const int base = (step & 1) * BUF_SZ, ch = P2_CH + (step & 1) * 1536;
#pragma unroll
            for (int ct = 0; ct < 2; ++ct) { const f32x4 em = *(const LAS f32x4*)(lds + ch + (32 * cw + 16 * ct + 4 * fq) * 4);
#pragma unroll
                for (int nt = 0; nt < 4; ++nt) { const f32x4 v = S[ct][nt] * em; v2u z; z.x = pk2m(v[0], v[1]); z.y = pk2m(v[2], v[3]);
                    *(LAS v2u*)(lds + P2_ST + ((16 * nt + fr) * SQ + 32 * cw + 16 * ct + 4 * fq) * 2) = z; } }
            {   const int ti0 = cw < 2 ? 3 : 2, sj0 = (cw & 1) * 2;
                const int ti1 = cw == 3 ? 1 : ti0, sj1 = cw == 3 ? 1 : sj0 + 1;
                const int ti2 = cw == 0 ? 0 : 1; const bool v2 = !(cw & 1);
                f32x4 a0 = (f32x4){0.f, 0.f, 0.f, 0.f}, a1 = a0, a2 = a0;
#pragma unroll
                for (int ks = 0; ks < 4; ++ks) {
                    a0 = MFMA16(frag(lds, base + B_KR, 16 * sj0, ks, SQ, fr, fq), frag(lds, base + B_QR, 16 * ti0, ks, SQ, fr, fq), a0);
                    a1 = MFMA16(frag(lds, base + B_KR, 16 * sj1, ks, SQ, fr, fq), frag(lds, base + B_QR, 16 * ti1, ks, SQ, fr, fq), a1);
                    if (v2) a2 = MFMA16(frag(lds, base + B_KR, 0, ks, SQ, fr, fq), frag(lds, base + B_QR, 16 * ti2, ks, SQ, fr, fq), a2);
                }
#pragma unroll
                for (int j = 0; j < 4; ++j) { const bool keep = (4 * fq + j <= fr); if (ti0 == sj0) a0[j] = keep ? a0[j] : 0.f; if (ti1 == sj1) a1[j] = keep ? a1[j] : 0.f; if (ti2 == 0) a2[j] = keep ? a2[j] : 0.f; }
                { v2u z; z.x = pk2m(a0[0], a0[1]); z.y = pk2m(a0[2], a0[3]); *(LAS v2u*)(lds + P2_P + ((16 * ti0 + fr) * SK + 16 * sj0 + 4 * fq) * 2) = z; }
                { v2u z; z.x = pk2m(a1[0], a1[1]); z.y = pk2m(a1[2], a1[3]); *(LAS v2u*)(lds + P2_P + ((16 * ti1 + fr) * SK + 16 * sj1 + 4 * fq) * 2) = z; }
                if (v2) { v2u z; z.x = pk2m(a2[0], a2[1]); z.y = pk2m(a2[2], a2[3]); *(LAS v2u*)(lds + P2_P + ((16 * ti2 + fr) * SK + 4 * fq) * 2) = z; }
            }
#pragma unroll
            for (int ct = 0; ct < 2; ++ct) {
                const f32x4 el = *(const LAS f32x4*)(lds + ch + 512 + (32 * cw + 16 * ct + 4 * fq) * 4);
#pragma unroll
                for (int nt = 0; nt < 4; ++nt) S[ct][nt] = el * S[ct][nt];
#pragma unroll
                for (int ks = 0; ks < 2; ++ks) { const bf16x8 ak = frag(lds, base + B_KRT, 32 * cw + 16 * ct, ks, SK, fr, fq);
#pragma unroll
                    for (int nt = 0; nt < 4; ++nt) S[ct][nt] = MFMA16(ak, frag(lds, base + B_VT, 16 * nt, ks, SK, fr, fq), S[ct][nt]); }
            }
        }
        LBAR();
        if (prod) {
            if (n1 < 32) {
                const int base = (n1 & 1) * BUF_SZ, ch = P2_CH + (n1 & 1) * 1536;
                f32x2 off = (f32x2){1.f, 1.f}, emid, elast;
                {   const f32x2 g0 = *(const LAS f32x2*)(lds + P2_SEG + (0 * 128 + 2 * cp) * 4), g1 = *(const LAS f32x2*)(lds + P2_SEG + (1 * 128 + 2 * cp) * 4);
                    const f32x2 g2 = *(const LAS f32x2*)(lds + P2_SEG + (2 * 128 + 2 * cp) * 4), g3 = *(const LAS f32x2*)(lds + P2_SEG + (3 * 128 + 2 * cp) * 4);
                    emid = g0 * g1; elast = emid * g2 * g3; off = pw == 0 ? off : (pw == 1 ? g0 : (pw == 2 ? emid : emid * g2)); }
                f32x2 rmid; rmid.x = __builtin_amdgcn_rcpf(emid.x); rmid.y = __builtin_amdgcn_rcpf(emid.y);
                const f32x2 gk = elast * rmid;
#pragma unroll
                for (int hf = 0; hf < 2; ++hf) {
                    f32x2 bl[8];
#pragma unroll
                    for (int i8 = 0; i8 < 8; ++i8) { const int i = 8 * hf + i8;
                        const f32x2 kv = (f32x2){bf_lo(freg[i]), bf_hi(freg[i])}, q2 = (f32x2){bf_lo(qreg[i]), bf_hi(qreg[i])};
                        off = off * ((f32x2){1.f, 1.f} - kv);
                        f32x2 rE; rE.x = __builtin_amdgcn_rcpf(off.x); rE.y = __builtin_amdgcn_rcpf(off.y);
                        const f32x2 qr = q2 * (off * rmid); bl[i8] = kv * (emid * rE);
                        const int po = ((16 * pw + i) * SQ + 2 * cp) * 2;
                        *(LAS unsigned*)(lds + base + B_QR + po) = pk2(qr.x, qr.y); *(LAS unsigned*)(lds + base + B_KR + po) = pk2(bl[i8].x, bl[i8].y);
                    }
#pragma unroll
                    for (int i8 = 0; i8 < 8; ++i8) bl[i8] = bl[i8] * gk;
                    { v4u t; t.x = pk2(bl[0].x, bl[1].x); t.y = pk2(bl[2].x, bl[3].x); t.z = pk2(bl[4].x, bl[5].x); t.w = pk2(bl[6].x, bl[7].x);
                      *(LAS v4u*)(lds + base + B_KRT + ((2 * cp) * SK + 16 * pw + 8 * hf) * 2) = t;
                      t.x = pk2(bl[0].y, bl[1].y); t.y = pk2(bl[2].y, bl[3].y); t.z = pk2(bl[4].y, bl[5].y); t.w = pk2(bl[6].y, bl[7].y);
                      *(LAS v4u*)(lds + base + B_KRT + ((2 * cp + 1) * SK + 16 * pw + 8 * hf) * 2) = t; }
                }
                if (n1 + 1 < 32) {
#pragma unroll
                    for (int i = 0; i < 16; ++i) { qreg[i] = qnx[i]; freg[i] = knx[i]; } }
                if (pw == 0) { *(LAS f32x2*)(lds + ch + (2 * cp) * 4) = emid; *(LAS f32x2*)(lds + ch + 512 + (2 * cp) * 4) = elast; *(LAS f32x2*)(lds + ch + 1024 + (2 * cp) * 4) = elast * rmid; }
            }
        } else if (step >= 0) {
            const int base = (step & 1) * BUF_SZ, t0 = 16 * cw;
            f32x4 ao[4];
#pragma unroll
            for (int nt = 0; nt < 4; ++nt) ao[nt] = (f32x4){0.f, 0.f, 0.f, 0.f};
#pragma unroll
            for (int ks = 0; ks < 4; ++ks) { const bf16x8 bq = frag(lds, base + B_QR, t0, ks, SQ, fr, fq);
#pragma unroll
                for (int nt = 0; nt < 4; ++nt) ao[nt] = MFMA16(frag(lds, P2_ST, 16 * nt, ks, SQ, fr, fq), bq, ao[nt]); }
#pragma unroll
            for (int ks = 0; ks < 2; ++ks) if (ks == 0 || cw >= 2) { const bf16x8 bp = frag(lds, P2_P, t0, ks, SK, fr, fq);
#pragma unroll
                for (int nt = 0; nt < 4; ++nt) ao[nt] = MFMA16(frag(lds, base + B_VT, 16 * nt, ks, SK, fr, fq), bp, ao[nt]); }
            const int j = t0 + fr; const int tok = dir ? (tokbase + 64 * (31 - step) + 63 - j) : (tokbase + 64 * step + j);
#pragma unroll
            for (int nt = 0; nt < 4; ++nt) { v2u z; z.x = pk2m(ao[nt][0], ao[nt][1]); z.y = pk2m(ao[nt][2], ao[nt][3]); *(v2u*)(ob + (unsigned)(tok * 64 + 16 * nt + 4 * fq)) = z; }
        }
        LBAR();
    }
}

__device__ __forceinline__ void hgrn_phase(LAS unsigned char* lds, const Args& a, int bid, int nblk) {
    const bf16_t* proj = (const bf16_t*)(a.ws + WS_PROJ);
    for (int it = bid; it < 256; it += nblk) {
        const int item = (nblk == 256) ? (((it & 7) * 8 + (it >> 5)) * 4 + ((it >> 3) & 3)) : it;
        if ((item >> 1) & 1) hgrn_item<1>(lds, a, proj, item); else hgrn_item<0>(lds, a, proj, item);
    }
}

__device__ __forceinline__ void unpack8(const v4u u, float (&f)[8]) { f[0] = bf_lo(u.x); f[1] = bf_hi(u.x); f[2] = bf_lo(u.y); f[3] = bf_hi(u.y); f[4] = bf_lo(u.z); f[5] = bf_hi(u.z); f[6] = bf_lo(u.w); f[7] = bf_hi(u.w); }
__device__ __forceinline__ void conv_y(const bf16_t* proj, const LAS float* cw, int row, int e0, bool hasp, bool hasn, float (&y)[8]) {
    const size_t off = (size_t)row * 2048 + e0;
    float bg[8], u0[8], um[8], un[8];
    unpack8(__builtin_nontemporal_load((const v4u*)(proj + 5 * SECN + off)), bg); unpack8(*(const v4u*)(proj + 6 * SECN + off), u0);
    v4u zz; zz.x = 0u; zz.y = 0u; zz.z = 0u; zz.w = 0u;
    unpack8(hasp ? *(const v4u*)(proj + 6 * SECN + off - 2048) : zz, um); unpack8(hasn ? *(const v4u*)(proj + 6 * SECN + off + 2048) : zz, un);
    const f32x4 w00 = *(const LAS f32x4*)(cw + e0), w01 = *(const LAS f32x4*)(cw + e0 + 4), w10 = *(const LAS f32x4*)(cw + 2048 + e0), w11 = *(const LAS f32x4*)(cw + 2048 + e0 + 4), w20 = *(const LAS f32x4*)(cw + 4096 + e0), w21 = *(const LAS f32x4*)(cw + 4096 + e0 + 4);
#pragma unroll
    for (int j = 0; j < 8; ++j) { const float wa = j < 4 ? w00[j] : w01[j - 4], wb = j < 4 ? w10[j] : w11[j - 4], wc = j < 4 ? w20[j] : w21[j - 4];
        y[j] = bg[j] * (wa * um[j] + wb * u0[j] + wc * un[j]); }
}
__device__ __forceinline__ void mix_phase(LAS unsigned char* lds, const Args& a, int bid, int nblk) {
    const int lane = threadIdx.x & 63, w = threadIdx.x >> 6;
    const int gw = bid * 8 + w, NGW = nblk * 8;
    const bf16_t* proj = (const bf16_t*)(a.ws + WS_PROJ);
    const bf16_t* OF = (const bf16_t*)(a.ws + WS_OF);
    LAS float* hw = (LAS float*)lds; LAS float* cnw = hw + 2048; LAS float* cw = hw + 4096;
    {   const f32x4* s0 = (const f32x4*)a.in[5]; const f32x4* s1 = (const f32x4*)a.in[7]; const f32x4* s2 = (const f32x4*)a.in[6];
        LAS f32x4* d = (LAS f32x4*)lds;
        for (int i = threadIdx.x; i < 512; i += 512) { d[i] = s0[i]; d[512 + i] = s1[i]; }
        for (int i = threadIdx.x; i < 1536; i += 512) d[1024 + i] = s2[i];
        __syncthreads(); }
    bf16_t* cat = (bf16_t*)(a.ws + WS_CAT);
    for (int row = gw; row < MTOK; row += NGW) {
        const int t = row & (SEQL - 1);
        const bool hasp = t > 0, hasn = t < SEQL - 1;
#pragma unroll 1
        for (int ps = 0; ps < 4; ++ps) {
            const int e0 = ps * 512 + lane * 8; const size_t off = (size_t)row * 2048 + e0;
            const size_t io = ((size_t)(((row >> 11) * 64 + (e0 >> 7) * 4 + ((e0 >> 6) & 1)) * 2048 + t) * 64) + (e0 & 63);
            float o[8], ob8[8]; float ss = 0.f; unpack8(__builtin_nontemporal_load((const v4u*)(OF + io)), o); unpack8(__builtin_nontemporal_load((const v4u*)(OF + io + (size_t)2 * 2048 * 64)), ob8);
#pragma unroll
            for (int j = 0; j < 8; ++j) o[j] += ob8[j];
#pragma unroll
            for (int j = 0; j < 8; ++j) ss += o[j] * o[j];
            ss += __shfl_xor(ss, 1); ss += __shfl_xor(ss, 2); ss += __shfl_xor(ss, 4); ss += __shfl_xor(ss, 8);
            const float rstd = __builtin_amdgcn_rsqf(ss * (1.f / 128.f) + EPSV);
            float z[8]; unpack8(__builtin_nontemporal_load((const v4u*)(proj + 4 * SECN + off)), z);
            const f32x4 g0 = *(const LAS f32x4*)(hw + e0), g1 = *(const LAS f32x4*)(hw + e0 + 4);
            float r[8];
#pragma unroll
            for (int j = 0; j < 8; ++j) r[j] = o[j] * rstd * (j < 4 ? g0[j] : g1[j - 4]) * z[j] * sigm(z[j]);
            v4u q; q.x = pk2(r[0], r[1]); q.y = pk2(r[2], r[3]); q.z = pk2(r[4], r[5]); q.w = pk2(r[6], r[7]);
            *(v4u*)(cat + (size_t)row * 4096 + e0) = q;
        }
        float ss = 0.f; unsigned yp[4][4];
#pragma unroll
        for (int ps = 0; ps < 4; ++ps) { float y[8]; __builtin_amdgcn_sched_barrier(0); conv_y(proj, cw, row, ps * 512 + lane * 8, hasp, hasn, y);
#pragma unroll
            for (int j = 0; j < 8; ++j) ss += y[j] * y[j];
#pragma unroll
            for (int j = 0; j < 4; ++j) yp[ps][j] = pk2(y[2 * j], y[2 * j + 1]); }
        const float rstd = __builtin_amdgcn_rsqf(wave_sum(ss) * (1.f / 2048.f) + EPSV);
#pragma unroll
        for (int ps = 0; ps < 4; ++ps) {
            const int e0 = ps * 512 + lane * 8; const size_t off = (size_t)row * 2048 + e0;
            float y[8]; { v4u t; t.x = yp[ps][0]; t.y = yp[ps][1]; t.z = yp[ps][2]; t.w = yp[ps][3]; unpack8(t, y); }
            float z[8]; unpack8(__builtin_nontemporal_load((const v4u*)(proj + 8 * SECN + off)), z);
            const f32x4 g0 = *(const LAS f32x4*)(cnw + e0), g1 = *(const LAS f32x4*)(cnw + e0 + 4);
            float r[8];
#pragma unroll
            for (int j = 0; j < 8; ++j) r[j] = y[j] * rstd * (j < 4 ? g0[j] : g1[j - 4]) * z[j] * sigm(z[j]);
            v4u q; q.x = pk2(r[0], r[1]); q.y = pk2(r[2], r[3]); q.z = pk2(r[4], r[5]); q.w = pk2(r[6], r[7]);
            *(v4u*)(cat + (size_t)row * 4096 + 2048 + e0) = q;
        }
    }
}

__device__ __forceinline__ void final_phase(const Args& a, int bid, int nblk) {
    const int lane = threadIdx.x & 63, w = threadIdx.x >> 6;
    const int gw = bid * 8 + w, NGW = nblk * 8;
    const float* part = (const float*)(a.ws + WS_PART); const float* fw = a.in[11];
    for (int row = gw; row < MTOK; row += NGW) {
        const float ps = lane < 32 ? part[(size_t)row * 32 + lane] : 0.f;
        const float rstd = __builtin_amdgcn_rsqf(wave_sum(ps) * (1.f / 2048.f) + EPSV);
        f32x4* o = (f32x4*)(a.out + (size_t)row * 2048) + lane;
#pragma unroll
        for (int j = 0; j < 8; ++j) { const f32x4 g = *((const f32x4*)fw + lane + 64 * j); f32x4 v = o[64 * j]; v.x *= rstd * g.x; v.y *= rstd * g.y; v.z *= rstd * g.z; v.w *= rstd * g.w; o[64 * j] = v; }
    }
}

#define RLX_AGENT __ATOMIC_RELAXED, __HIP_MEMORY_SCOPE_AGENT
#define XB_TMO      128
#define XB_XCNT(j)  (256  + 64 * (j))
#define XB_XSUB(j)  (1280 + 64 * (j))
#define XB_XGEN(j)  (2304 + 64 * (j))
#define XB_TOP      3328
#define XB_TOPGEN   3392
#define XCD_BAR_WORDS 3456
#define XB_SPIN_CAP (1u << 18)

__device__ __forceinline__ unsigned xb_ld(unsigned* p)              { return __hip_atomic_load(p, __ATOMIC_RELAXED, __HIP_MEMORY_SCOPE_AGENT); }
__device__ __forceinline__ unsigned xb_add(unsigned* p, unsigned v) { return __hip_atomic_fetch_add(p, v, __ATOMIC_RELAXED, __HIP_MEMORY_SCOPE_AGENT); }
__device__ __forceinline__ unsigned xb_xcc_id() { return (unsigned)__builtin_amdgcn_s_getreg((3 << 11) | 20) & 0xFu; }
#define XB_SPIN(cond, bar) do { unsigned _sp = 0; while (cond) { __builtin_amdgcn_s_sleep(1); \
    if ((++_sp & 255u) == 0u) { if (xb_ld(&(bar)[XB_TMO])) break; if (_sp > XB_SPIN_CAP) { atomicAdd(&(bar)[XB_TMO], 1u); break; } } } } while (0)

struct XcdBarrier {
    unsigned* bar; unsigned x;
    volatile LAS unsigned* st;
};

__device__ __forceinline__ XcdBarrier xcd_barrier_post(unsigned* bar, volatile LAS unsigned* st) {
    XcdBarrier b; b.bar = bar; b.x = xb_xcc_id(); b.st = st;
    if (threadIdx.x == 0) (void)xb_add(&bar[XB_XCNT(b.x)], 1u);
    return b;
}
__device__ __forceinline__ void xcd_barrier_complete(unsigned* bar, unsigned x, unsigned& nloc, unsigned& nx) {
    const unsigned G = gridDim.x * gridDim.y * gridDim.z;
    unsigned sum, cnt, mine, sp = 0u;
    for (;;) {
        sum = 0u; cnt = 0u; mine = 0u;
#pragma unroll
        for (unsigned j = 0; j < 16; ++j) { const unsigned c = xb_ld(&bar[XB_XCNT(j)]); sum += c; cnt += (c > 0u) ? 1u : 0u; mine = (j == x) ? c : mine; }
        if (sum == G) break;
        __builtin_amdgcn_s_sleep(1);
        if ((++sp & 255u) == 0u) { if (xb_ld(&bar[XB_TMO])) break; if (sp > XB_SPIN_CAP) { atomicAdd(&bar[XB_TMO], 1u); break; } }
    }
    nloc = mine > 0u ? mine : 1u; nx = cnt > 0u ? cnt : 1u;
}

__device__ __forceinline__ void xcd_barrier(const XcdBarrier& b) {
    asm volatile("s_waitcnt vmcnt(0)" ::: "memory");
    __syncthreads();
    if (threadIdx.x == 0) {
        unsigned* bar = b.bar;
        __builtin_amdgcn_s_waitcnt(0);
        unsigned nloc = b.st[0], nx = b.st[1];
        if (nloc == 0u) { xcd_barrier_complete(bar, b.x, nloc, nx); b.st[0] = nloc; b.st[1] = nx; }
        const unsigned old = xb_add(&bar[XB_XSUB(b.x)], 1u);
        const unsigned gen = old / nloc;
        if (old + 1u == (gen + 1u) * nloc) {
            __builtin_amdgcn_fence(__ATOMIC_RELEASE, "agent");
            asm volatile("s_waitcnt vmcnt(0)" ::: "memory");
            const unsigned og = xb_add(&bar[XB_TOP], 1u);
            const unsigned tg = og / nx;
            if (og + 1u == (tg + 1u) * nx) xb_add(&bar[XB_TOPGEN], 1u);
            else XB_SPIN(xb_ld(&bar[XB_TOPGEN]) == tg, bar);
            __builtin_amdgcn_fence(__ATOMIC_ACQUIRE, "agent");
            xb_add(&bar[XB_XGEN(b.x)], 1u);
            asm volatile("s_waitcnt vmcnt(0)" ::: "memory");
        } else {
            XB_SPIN(xb_ld(&bar[XB_XGEN(b.x)]) == gen, bar);
            __builtin_amdgcn_fence(__ATOMIC_ACQUIRE, "agent");
            asm volatile("s_waitcnt vmcnt(0)" ::: "memory");
        }
    }
    __syncthreads();
}

constexpr int NPHASE = 7;
__global__ void __launch_bounds__(512, 2) hymba_fwd(Args a) {
    extern __shared__ __attribute__((aligned(16))) unsigned char shm[];
    LAS unsigned char* lds = (LAS unsigned char*)shm;
    cg::grid_group grid = cg::this_grid();
    const int bid = blockIdx.x, nblk = gridDim.x;
    unsigned char* ws = a.ws;
#if MK_LAUNCHES == 1
    if (threadIdx.x < 16) ((volatile LAS unsigned*)(lds + MISC_OFF))[threadIdx.x] = 0u;
    __syncthreads();
    XcdBarrier bar = xcd_barrier_post((unsigned*)(ws + WS_CTL), (volatile LAS unsigned*)(lds + MISC_OFF));
    if (a.ph_hi == 0x7fffffff) grid.sync();
#define IN(k) true
#define SEAM() xcd_barrier(bar)
#else
    const int lo = a.ph_lo, hi = a.ph_hi;
#define IN(k) (lo <= (k) && (k) < hi)
#define SEAM() do {} while (0)
#endif
    if (TSPH == 0 && bid == 0 && threadIdx.x == 0) ((unsigned long long*)(ws + WS_CTL + 32768))[0] = __builtin_amdgcn_s_memrealtime();
    if (IN(0)) { if (PHM & 1) prep_phase(lds, a, bid, nblk); SEAM(); if (REP & 1) { prep_phase(lds, a, bid, nblk); SEAM(); } }
    if (TSPH == 0 && bid == 0 && threadIdx.x == 0) ((unsigned long long*)(ws + WS_CTL + 32768))[1] = __builtin_amdgcn_s_memrealtime();
    if (TSPH == 1 && bid == 0 && threadIdx.x == 0) ((unsigned long long*)(ws + WS_CTL + 32768))[0] = __builtin_amdgcn_s_memrealtime();
    if (IN(1)) { if (PHM & 2) {
            pg8::Gemm g; g.A = (const bf16_t*)(ws + WS_HN); g.Bt = (const bf16_t*)(ws + WS_WIN); g.M = MTOK; g.N = NIN; g.K = DM;
            pg8::StaticOrder S; S.init(g.M, g.N, nblk, bid); pg8::EpiProj E; E.O = (bf16_t*)(ws + WS_PROJ); E.LBO = a.in[4];
            pg8::gemm_phase<pg8::EpiProj, pg8::StaticOrder, true, true>(lds, g, S, E); }
        SEAM(); }
    if (REP & 2) { if (PHM & 2) {
            pg8::Gemm g; g.A = (const bf16_t*)(ws + WS_HN); g.Bt = (const bf16_t*)(ws + WS_WIN); g.M = MTOK; g.N = NIN; g.K = DM;
            pg8::StaticOrder S; S.init(g.M, g.N, nblk, bid); pg8::EpiProj E; E.O = (bf16_t*)(ws + WS_PROJ); E.LBO = a.in[4];
            pg8::gemm_phase<pg8::EpiProj, pg8::StaticOrder, true, true>(lds, g, S, E); }
        SEAM(); }
    if (TSPH == 1 && bid == 0 && threadIdx.x == 0) ((unsigned long long*)(ws + WS_CTL + 32768))[1] = __builtin_amdgcn_s_memrealtime();
    if (TSPH == 2 && bid == 0 && threadIdx.x == 0) ((unsigned long long*)(ws + WS_CTL + 32768))[0] = __builtin_amdgcn_s_memrealtime();
    if (IN(2)) { if (PHM & 4) hgrn_phase(lds, a, bid, nblk); SEAM(); if (REP & 4) { hgrn_phase(lds, a, bid, nblk); SEAM(); } }
    if (TSPH == 2 && bid == 0 && threadIdx.x == 0) ((unsigned long long*)(ws + WS_CTL + 32768))[1] = __builtin_amdgcn_s_memrealtime();
    if (TSPH == 3 && bid == 0 && threadIdx.x == 0) ((unsigned long long*)(ws + WS_CTL + 32768))[0] = __builtin_amdgcn_s_memrealtime();
    if (IN(3)) { if (PHM & 8) mix_phase(lds, a, bid, nblk); SEAM(); if (REP & 8) { mix_phase(lds, a, bid, nblk); SEAM(); } }
    if (TSPH == 3 && bid == 0 && threadIdx.x == 0) ((unsigned long long*)(ws + WS_CTL + 32768))[1] = __builtin_amdgcn_s_memrealtime();
    if (TSPH == 4 && bid == 0 && threadIdx.x == 0) ((unsigned long long*)(ws + WS_CTL + 32768))[0] = __builtin_amdgcn_s_memrealtime();
    if (IN(4)) { if (PHM & 16) {
            pg8::Gemm g; g.A = (const bf16_t*)(ws + WS_CAT); g.Bt = (const bf16_t*)(ws + WS_WOUT); g.M = MTOK; g.N = DM; g.K = DMIX;
            pg8::StaticOrder S; S.init(g.M, g.N, nblk, bid); pg8::EpiH E; E.X = a.in[0]; E.H = (float*)(ws + WS_H); E.HB = (bf16_t*)(ws + WS_HB);
            pg8::gemm_phase<pg8::EpiH, pg8::StaticOrder, false, true>(lds, g, S, E); }
        SEAM(); }
    if (REP & 16) { if (PHM & 16) {
            pg8::Gemm g; g.A = (const bf16_t*)(ws + WS_CAT); g.Bt = (const bf16_t*)(ws + WS_WOUT); g.M = MTOK; g.N = DM; g.K = DMIX;
            pg8::StaticOrder S; S.init(g.M, g.N, nblk, bid); pg8::EpiH E; E.X = a.in[0]; E.H = (float*)(ws + WS_H); E.HB = (bf16_t*)(ws + WS_HB);
            pg8::gemm_phase<pg8::EpiH, pg8::StaticOrder, false, true>(lds, g, S, E); }
        SEAM(); }
    if (TSPH == 4 && bid == 0 && threadIdx.x == 0) ((unsigned long long*)(ws + WS_CTL + 32768))[1] = __builtin_amdgcn_s_memrealtime();
    if (TSPH == 5 && bid == 0 && threadIdx.x == 0) ((unsigned long long*)(ws + WS_CTL + 32768))[0] = __builtin_amdgcn_s_memrealtime();
    if (IN(5)) {
        if (PHM & 32) {   pg8::Gemm g; g.A = (const bf16_t*)(ws + WS_PB); g.Bt = (const bf16_t*)(ws + WS_WP); g.M = MTOK; g.N = DM; g.K = PLED;
            pg8::StaticOrder S; S.init(g.M, g.N, nblk, bid); pg8::EpiPle E; E.O = (bf16_t*)(ws + WS_OF);
            pg8::gemm_phase<pg8::EpiPle, pg8::StaticOrder, false, true>(lds, g, S, E); }
        if (PHM & 64) {   pg8::Gemm g; g.A = (const bf16_t*)(ws + WS_HB); g.Bt = (const bf16_t*)(ws + WS_WG); g.M = MTOK; g.N = DM; g.K = DM;
            pg8::StaticOrder S; S.init(g.M, g.N, nblk, bid); pg8::EpiGateNorm E; E.HBF = (const bf16_t*)(ws + WS_HB); E.PL = (const bf16_t*)(ws + WS_OF); E.O = a.out; E.XS = (float*)(ws + WS_PART);
            E.CNT = (unsigned*)(ws + WS_CTL + 16384); E.FW = a.in[11];
            pg8::gemm_phase<pg8::EpiGateNorm, pg8::StaticOrder, false, true>(lds, g, S, E); }
    }
    if (TSPH >= 0 && TSPH < 6) { __syncthreads(); if (bid == 0 && threadIdx.x == 0) { const unsigned long long* tsp = (const unsigned long long*)(ws + WS_CTL + 32768); a.out[0] = (float)(tsp[1] - tsp[0]) * 0.01f; } }
}

extern "C" void kernel_launch(void* const* d_in, const int* in_sizes, int n_in, void* d_out, int out_size, void* d_ws, size_t ws_size, hipStream_t stream) {
    static int grid = 0;
    if (grid == 0) {
        if (n_in != 12 || out_size != MTOK * DM || ws_size < WS_END) { fprintf(stderr, "kernel_launch: unexpected shapes (n_in %d out %d ws %zu)\n", n_in, out_size, ws_size); grid = -1; return; }
        int dev = 0, cus = 0, per_cu = 0;
        hipGetDevice(&dev); hipDeviceGetAttribute(&cus, hipDeviceAttributeMultiprocessorCount, dev);
        if (hipFuncSetAttribute((const void*)hymba_fwd, hipFuncAttributeMaxDynamicSharedMemorySize, LDS_BYTES) != hipSuccess) { fprintf(stderr, "kernel_launch: hipFuncSetAttribute failed\n"); grid = -1; return; }
        if (hipOccupancyMaxActiveBlocksPerMultiprocessor(&per_cu, (const void*)hymba_fwd, 512, LDS_BYTES) != hipSuccess || per_cu < 1) { fprintf(stderr, "kernel_launch: occupancy query failed (%d)\n", per_cu); (void)hipGetLastError(); per_cu = 1; }
        grid = cus * (per_cu > 1 ? 1 : per_cu);
        if (grid != 256) fprintf(stderr, "kernel_launch: grid %d != 256: the fused final norm needs one GEMM3 unit per workgroup\n", grid);
        if (grid <= 0) grid = 256;
    }
    if (grid < 0) return;
    Args a{};
    if (hipMemsetAsync((char*)d_ws + WS_CTL, 0, 32768, stream) != hipSuccess) { fprintf(stderr, "kernel_launch: memset failed\n"); return; }
    for (int i = 0; i < 12; ++i) a.in[i] = (const float*)d_in[i];
    a.out = (float*)d_out; a.ws = (unsigned char*)d_ws;
#if MK_LAUNCHES == 1
    a.ph_lo = 0; a.ph_hi = NPHASE;
    void* args[] = {&a};
    hipError_t e = hipLaunchCooperativeKernel((const void*)hymba_fwd, dim3(grid), dim3(512), args, LDS_BYTES, stream);
    if (e != hipSuccess) fprintf(stderr, "cooperative launch failed: %s (grid %d)\n", hipGetErrorString(e), grid);
#else
    for (int ph = 0; ph < NPHASE; ++ph) { a.ph_lo = ph; a.ph_hi = ph + 1; hipLaunchKernelGGL(hymba_fwd, dim3(grid), dim3(512), LDS_BYTES, stream, a); }
#endif
}
```
